# Optimizing an MI355X kernel written in HIP

```python
import jax, jax.numpy as jnp
from jax import lax
import numpy as np

D_MODEL = 1024
BATCH = 8
SEQ = 2048
DEPTH = 4

N_META = 16
N_A_LAYERS = DEPTH // 2
N_B_LAYERS = DEPTH - N_A_LAYERS
LRU_WIDTH = D_MODEL
LRU_BLOCKS = 4
LRU_BLOCK = LRU_WIDTH // LRU_BLOCKS
CONV_WIDTH = 4
LRU_C = 8.0
ATTN_HEADS = 8
HEAD_DIM = 128
ATTN_WIDTH = ATTN_HEADS * HEAD_DIM
Q_BLOCK = 128
EPS = 1e-6

kernel_name = "yoco_hawk_fox_hybrid"


def rms_norm(x, g):
    xf = x.astype(jnp.float32)
    return xf * lax.rsqrt(jnp.mean(xf * xf, axis=-1, keepdims=True) + EPS) * g.astype(jnp.float32)


def causal_depthwise_conv(u, w, b):
    T = u.shape[1]
    up = jnp.pad(u, ((0, 0), (CONV_WIDTH - 1, 0), (0, 0)))
    out = b.astype(jnp.float32)
    for k in range(CONV_WIDTH):
        out = out + up[:, k:k + T] * w[k]
    return out


def block_diag_linear(u, w, b):
    B, T, _ = u.shape
    ub = u.reshape(B, T, LRU_BLOCKS, LRU_BLOCK)
    return jnp.einsum('btni,nij->btnj', ub, w).reshape(B, T, LRU_WIDTH) + b


def rg_lru(u, w_r, b_r, w_i, b_i, lam):
    r = jax.nn.sigmoid(block_diag_linear(u, w_r, b_r))
    i = jax.nn.sigmoid(block_diag_linear(u, w_i, b_i))
    log_a = -LRU_C * r * jax.nn.softplus(-lam.astype(jnp.float32))
    a = jnp.exp(log_a)
    mult = jnp.sqrt(-jnp.expm1(2.0 * log_a))
    bterm = mult * i * u

    def combine(left, right):
        a1, b1 = left
        a2, b2 = right
        return a1 * a2, a2 * b1 + b2

    _, h = lax.associative_scan(combine, (a, bterm), axis=1)
    return h


def recurrent_layer(x, g, w_in, conv_w, conv_b, w_r, b_r, w_i, b_i, lam, w_out):
    h = rms_norm(x, g)
    ug = h @ w_in
    u, gate = ug[..., :LRU_WIDTH], ug[..., LRU_WIDTH:]
    u = causal_depthwise_conv(u, conv_w, conv_b)
    y = rg_lru(u, w_r, b_r, w_i, b_i, lam)
    return (y * jax.nn.silu(gate)) @ w_out


def shared_kv(x, g_kv, w_kv, b_f, g_k):
    B, T, _ = x.shape
    h = rms_norm(x, g_kv)
    kvf = h @ w_kv
    k = kvf[..., :ATTN_WIDTH].reshape(B, T, ATTN_HEADS, HEAD_DIM)
    v = kvf[..., ATTN_WIDTH:2 * ATTN_WIDTH].reshape(B, T, ATTN_HEADS, HEAD_DIM)
    f_logit = kvf[..., 2 * ATTN_WIDTH:] + b_f
    k = rms_norm(k, g_k)
    cum = jnp.cumsum(jax.nn.log_sigmoid(f_logit.astype(jnp.float32)), axis=1)
    return (k.transpose(0, 2, 1, 3), v.astype(jnp.float32).transpose(0, 2, 1, 3), cum.transpose(0, 2, 1))


def forgetting_attention(q, k, v, cum):
    T = q.shape[2]
    scale = HEAD_DIM ** -0.5
    neg = jnp.finfo(jnp.float32).min
    bounds = [(0, N_META)] + [(s, min(s + Q_BLOCK, T)) for s in range(N_META, T, Q_BLOCK)]
    outs = []
    for s0, s1 in bounds:
        qb = q[:, :, s0:s1]
        kb = k[:, :, :s1]
        vb = v[:, :, :s1]
        logits = (jnp.einsum('bhqd,bhkd->bhqk', qb, kb) * scale
                  + cum[:, :, s0:s1, None] - cum[:, :, None, :s1])
        mask = jnp.arange(s0, s1)[:, None] >= jnp.arange(s1)[None, :]
        p = jax.nn.softmax(jnp.where(mask, logits, neg), axis=-1)
        outs.append(jnp.einsum('bhqk,bhkd->bhqd', p, vb))
    return jnp.concatenate(outs, axis=2)


def attention_layer(x, g, w_in, g_q, w_out, k, v, cum):
    B, T, _ = x.shape
    h = rms_norm(x, g)
    qg = h @ w_in
    q, gate = qg[..., :ATTN_WIDTH], qg[..., ATTN_WIDTH:]
    q = rms_norm(q.reshape(B, T, ATTN_HEADS, HEAD_DIM), g_q).transpose(0, 2, 1, 3)
    o = forgetting_attention(q, k, v, cum)
    o = o.transpose(0, 2, 1, 3).reshape(B, T, ATTN_WIDTH)
    return (o * jax.nn.silu(gate)) @ w_out


def setup_inputs(seed: int = 0) -> dict:
    key = jax.random.key(seed)
    ks = jax.random.split(key, 24)
    nA, nB = N_A_LAYERS, N_B_LAYERS
    f32 = jnp.float32

    def nrm(k, shape, scale):
        return jax.random.normal(k, shape, f32) * scale

    a8 = jax.random.uniform(ks[10], (nA, LRU_WIDTH), f32, 0.9, 0.999)
    a = a8 ** (1.0 / LRU_C)
    lam = jnp.log(a) - jnp.log1p(-a)
    b_f = jnp.linspace(1.0, 5.0, ATTN_HEADS, dtype=f32) + nrm(ks[14], (ATTN_HEADS,), 0.1)
    return {
        "x": nrm(ks[0], (BATCH, SEQ, D_MODEL), 1.0),
        "meta_tokens": nrm(ks[1], (N_META, D_MODEL), 1.0),
        "a_norm": 1.0 + nrm(ks[2], (nA, D_MODEL), 0.02),
        "a_w_in": nrm(ks[3], (nA, D_MODEL, 2 * LRU_WIDTH), D_MODEL ** -0.5),
        "a_conv_w": nrm(ks[4], (nA, CONV_WIDTH, LRU_WIDTH), CONV_WIDTH ** -0.5),
        "a_conv_b": nrm(ks[5], (nA, LRU_WIDTH), 0.01),
        "a_w_r": nrm(ks[6], (nA, LRU_BLOCKS, LRU_BLOCK, LRU_BLOCK), LRU_BLOCK ** -0.5),
        "a_b_r": nrm(ks[7], (nA, LRU_WIDTH), 0.01),
        "a_w_i": nrm(ks[8], (nA, LRU_BLOCKS, LRU_BLOCK, LRU_BLOCK), LRU_BLOCK ** -0.5),
        "a_b_i": nrm(ks[9], (nA, LRU_WIDTH), 0.01),
        "a_lambda": lam,
        "a_w_out": nrm(ks[11], (nA, LRU_WIDTH, D_MODEL), LRU_WIDTH ** -0.5),
        "kv_norm": 1.0 + nrm(ks[12], (D_MODEL,), 0.02),
        "w_kv": nrm(ks[13], (D_MODEL, 2 * ATTN_WIDTH + ATTN_HEADS), D_MODEL ** -0.5),
        "b_f": b_f,
        "k_norm": 1.0 + nrm(ks[15], (HEAD_DIM,), 0.02),
        "b_norm": 1.0 + nrm(ks[16], (nB, D_MODEL), 0.02),
        "b_w_in": nrm(ks[17], (nB, D_MODEL, 2 * ATTN_WIDTH), D_MODEL ** -0.5),
        "q_norm": 1.0 + nrm(ks[18], (nB, HEAD_DIM), 0.02),
        "b_w_out": nrm(ks[19], (nB, ATTN_WIDTH, D_MODEL), ATTN_WIDTH ** -0.5),
    }


def reference(x, meta_tokens, a_norm, a_w_in, a_conv_w, a_conv_b, a_w_r, a_b_r, a_w_i, a_b_i,
              a_lambda, a_w_out, kv_norm, w_kv, b_f, k_norm, b_norm, b_w_in, q_norm, b_w_out):
    B = x.shape[0]
    meta = jnp.broadcast_to(meta_tokens[None].astype(x.dtype), (B, N_META, D_MODEL))
    h = jnp.concatenate([meta, x], axis=1)
    k = v = cum = None
    for l in range(DEPTH):
        if l < N_A_LAYERS:
            out = recurrent_layer(h, a_norm[l], a_w_in[l], a_conv_w[l], a_conv_b[l], a_w_r[l],
                                  a_b_r[l], a_w_i[l], a_b_i[l], a_lambda[l], a_w_out[l])
        else:
            if l == N_A_LAYERS:
                k, v, cum = shared_kv(h, kv_norm, w_kv, b_f, k_norm)
            j = l - N_A_LAYERS
            out = attention_layer(h, b_norm[j], b_w_in[j], q_norm[j], b_w_out[j], k, v, cum)
        h = h + out.astype(h.dtype)
    return h[:, N_META:]
```

```cpp
#include <hip/hip_runtime.h>
#include <hip/hip_bf16.h>
#include <cstdio>
#include <cstdint>

#define GAS __attribute__((address_space(1)))
#define LAS __attribute__((address_space(3)))
typedef unsigned short bf16_t;
typedef short bf16x8 __attribute__((ext_vector_type(8)));
typedef float f32x4 __attribute__((ext_vector_type(4)));
typedef float f32x2 __attribute__((ext_vector_type(2)));
typedef unsigned u32x4 __attribute__((ext_vector_type(4)));
typedef unsigned u32x2 __attribute__((ext_vector_type(2)));
typedef GAS unsigned gu32;

constexpr int NB = 8, SEQ = 2048, DM = 1024, NMETA = 16, TP = 2112, MPOS = 48, RPOS = 64, MROWS = NB * SEQ;
constexpr int NH = 8, HD = 128;
constexpr float EPS = 1e-6f;
constexpr float SCALE = 0.08838834764831845f;
constexpr int NWAVES = 8, NTHREADS = 512;
constexpr int NPHASES = 13;

#ifndef GEMM_FAST
#define GEMM_FAST 1
#endif
#ifndef ATTN_FAST
#define ATTN_FAST 1
#endif
#ifndef SCAN_FAST
#define SCAN_FAST 1
#endif
#ifndef PROBE_PHASE
#define PROBE_PHASE (-1)
#define PROBE_REP 1
#endif
#define NREP(k) ((k) == PROBE_PHASE ? PROBE_REP : 1)
#ifndef PANEL_SYNC
#define PANEL_SYNC 1
#endif
#ifndef MK_PER_PHASE
#define MK_PER_PHASE 0
#endif

constexpr size_t MiB = 1u << 20;
constexpr size_t WS_CTL = 0, CTL_ZERO_BYTES = 1 * MiB;
constexpr int CW_PANEL = 10240, CW_METAF = 13312;
constexpr int CW_TMO = 0, CW_CODE = 1, CW_BAR = 4096, CW_Q = 8192;
constexpr size_t CTL_SS = 65536;
constexpr size_t CTL_SSM = CTL_SS + 4 * MROWS * 4;
static_assert(CTL_SSM + 4 * 16 * 4 <= CTL_ZERO_BYTES, "ctl");
constexpr size_t WS_WA = 2 * MiB;
constexpr size_t WA_STRIDE = 7 * MiB, WA_WR = 4 * MiB, WA_WI = 4 * MiB + 512 * 1024, WA_WOUT = 5 * MiB;
constexpr size_t WS_WKVQ = 16 * MiB;
constexpr size_t WS_WINB1 = 24 * MiB;
constexpr size_t WS_WOUTB = 28 * MiB;
constexpr size_t WS_WF = 32 * MiB;
constexpr size_t WS_XFM = 32 * MiB + 65536;
constexpr size_t WS_LS = 33 * MiB;
constexpr size_t ACT_BYTES = (size_t)NB * TP * DM * 2;
constexpr size_t WS_XB = 34 * MiB, WS_U = 67 * MiB, WS_G = 100 * MiB, WS_YG = 133 * MiB, WS_K = 166 * MiB, WS_V = 199 * MiB, WS_END = 232 * MiB;
static_assert(ACT_BYTES == 33 * MiB, "act");

constexpr int RING_BYTES = 131072;
constexpr int EPI_OFF = RING_BYTES, EPI_BYTES = 8192;
constexpr int LDSCTL_OFF = EPI_OFF + EPI_BYTES, MISC_OFF = LDSCTL_OFF + 320;
constexpr int LDS_BYTES = 147456;
static_assert(MISC_OFF + 128 <= LDS_BYTES, "lds");

#define RLX_AGENT __ATOMIC_RELAXED, __HIP_MEMORY_SCOPE_AGENT
#define LDS_WAIT() asm volatile("s_waitcnt lgkmcnt(0)" ::: "memory")
__device__ __forceinline__ unsigned f2bf(float f) { unsigned u = __builtin_bit_cast(unsigned, f); return (u + 0x7fffu + ((u >> 16) & 1u)) >> 16; }
__device__ __forceinline__ unsigned pk2(float lo, float hi) { return f2bf(lo) | (f2bf(hi) << 16); }
__device__ __forceinline__ float bflo(unsigned w) { return __uint_as_float(w << 16); }
__device__ __forceinline__ float bfhi(unsigned w) { return __uint_as_float(w & 0xffff0000u); }
__device__ __forceinline__ float bf2f(bf16_t h) { return __uint_as_float((unsigned)h << 16); }
__device__ __forceinline__ float wave_sum(float v) {
#pragma unroll
    for (int o = 1; o < 64; o <<= 1) v += __shfl_xor(v, o);
    return v;
}
__device__ __forceinline__ float half_sum(float v) {
#pragma unroll
    for (int o = 1; o < 32; o <<= 1) v += __shfl_xor(v, o);
    return v;
}
__device__ __forceinline__ int opaque_tid_(int wv64) { unsigned m = ~0u; asm volatile("" : "+s"(m), "+s"(wv64)); return wv64 + (int)__builtin_amdgcn_mbcnt_hi(m, __builtin_amdgcn_mbcnt_lo(m, 0u)); }
#define opaque_tid() opaque_tid_(wv64_)
__device__ __forceinline__ int opaque_bid() { int b = blockIdx.x; asm volatile("" : "+s"(b)); return b; }
__device__ __forceinline__ float sigmoidf_(float x) { return __builtin_amdgcn_rcpf(1.0f + __builtin_amdgcn_exp2f(-1.4426950408889634f * x)); }
__device__ __forceinline__ int prow(int m) { return (m >> 11) * TP + RPOS + (m & 2047); }

#define XB_TMO      128
#define XB_XCNT(j)  (256  + 64 * (j))
#define XB_XSUB(j)  (1280 + 64 * (j))
#define XB_XGEN(j)  (2304 + 64 * (j))
#define XB_TOP      3328
#define XB_TOPGEN   3392
#define XCD_BAR_WORDS 3456
#define XB_SPIN_CAP (1u << 22)
__device__ __forceinline__ unsigned xb_ld(unsigned* p)              { return __hip_atomic_load(p, __ATOMIC_RELAXED, __HIP_MEMORY_SCOPE_AGENT); }
__device__ __forceinline__ unsigned xb_add(unsigned* p, unsigned v) { return __hip_atomic_fetch_add(p, v, __ATOMIC_RELAXED, __HIP_MEMORY_SCOPE_AGENT); }
__device__ __forceinline__ unsigned xb_xcc_id() { return (unsigned)__builtin_amdgcn_s_getreg((3 << 11) | 20) & 0xFu; }
#define XB_SPIN(cond, bar) do { unsigned _sp = 0; while (cond) { __builtin_amdgcn_s_sleep(1); \
    if ((++_sp & 255u) == 0u) { if (xb_ld(&(bar)[XB_TMO])) break; if (_sp > XB_SPIN_CAP) { atomicAdd(&(bar)[XB_TMO], 1u); break; } } } } while (0)
struct XcdBarrier { unsigned* bar; unsigned x; volatile LAS unsigned* st; };
__device__ __forceinline__ XcdBarrier xcd_barrier_post(unsigned* bar, volatile LAS unsigned* st, bool leader) {
    XcdBarrier b; b.bar = bar; b.x = xb_xcc_id(); b.st = st;
    if (leader) (void)xb_add(&bar[XB_XCNT(b.x)], 1u);
    return b;
}
__device__ __forceinline__ void xcd_barrier_complete(unsigned* bar, unsigned x, unsigned& nloc, unsigned& nx) {
    const unsigned G = gridDim.x * gridDim.y * gridDim.z;
    unsigned sum, cnt, mine, sp = 0u;
    for (;;) {
        sum = 0u; cnt = 0u; mine = 0u;
#pragma unroll
        for (unsigned j = 0; j < 16; ++j) { const unsigned c = xb_ld(&bar[XB_XCNT(j)]); sum += c; cnt += (c > 0u) ? 1u : 0u; mine = (j == x) ? c : mine; }
        if (sum == G) break;
        __builtin_amdgcn_s_sleep(1);
        if ((++sp & 255u) == 0u) { if (xb_ld(&bar[XB_TMO])) break; if (sp > XB_SPIN_CAP) { atomicAdd(&bar[XB_TMO], 1u); break; } }
    }
    nloc = mine > 0u ? mine : 1u; nx = cnt > 0u ? cnt : 1u;
}
__device__ __forceinline__ void xcd_barrier(const XcdBarrier& b, bool leader) {
    asm volatile("s_waitcnt vmcnt(0)" ::: "memory");
    __syncthreads();
    if (leader) {
        unsigned* bar = b.bar;
        __builtin_amdgcn_s_waitcnt(0);
        unsigned nloc = b.st[0], nx = b.st[1];
        if (nloc == 0u) { xcd_barrier_complete(bar, b.x, nloc, nx); b.st[0] = nloc; b.st[1] = nx; }
        const unsigned old = xb_add(&bar[XB_XSUB(b.x)], 1u);
        const unsigned gen = old / nloc;
        if (old + 1u == (gen + 1u) * nloc) {
            __builtin_amdgcn_fence(__ATOMIC_RELEASE, "agent");
            asm volatile("s_waitcnt vmcnt(0)" ::: "memory");
            const unsigned og = xb_add(&bar[XB_TOP], 1u);
            const unsigned tg = og / nx;
            __builtin_amdgcn_fence(__ATOMIC_ACQUIRE, "agent");
            if (og + 1u == (tg + 1u) * nx) xb_add(&bar[XB_TOPGEN], 1u);
            else XB_SPIN(xb_ld(&bar[XB_TOPGEN]) == tg, bar);
            xb_add(&bar[XB_XGEN(b.x)], 1u);
            asm volatile("s_waitcnt vmcnt(0)" ::: "memory");
        } else {
            __builtin_amdgcn_fence(__ATOMIC_ACQUIRE, "agent");
            XB_SPIN(xb_ld(&bar[XB_XGEN(b.x)]) == gen, bar);
            asm volatile("s_waitcnt vmcnt(0)" ::: "memory");
        }
    }
    __syncthreads();
}

struct Args { const float* in[20]; float* out; unsigned char* ws; int ph_lo, ph_hi; };
enum { I_X = 0, I_META, I_ANORM, I_AWIN, I_ACONVW, I_ACONVB, I_AWR, I_ABR, I_AWI, I_ABI, I_ALAM, I_AWOUT, I_KVNORM, I_WKV, I_BF, I_KNORM, I_BNORM, I_BWIN, I_QNORM, I_BWOUT };

__device__ __forceinline__ void wait_counter(unsigned* cnt, unsigned need, unsigned* tmo, bool leader) {
    if (leader) {
        __builtin_amdgcn_fence(__ATOMIC_ACQUIRE, "agent");
        unsigned sp = 0;
        while (__hip_atomic_load(cnt, __ATOMIC_RELAXED, __HIP_MEMORY_SCOPE_AGENT) < need) {
            __builtin_amdgcn_s_sleep(1);
            if ((++sp & 255u) == 0u) { if (__hip_atomic_load(tmo, __ATOMIC_RELAXED, __HIP_MEMORY_SCOPE_AGENT)) break; if (sp > (1u << 22)) { atomicAdd(tmo, 1u); break; } }
        }
        asm volatile("s_waitcnt vmcnt(0)" ::: "memory");
    }
    __syncthreads();
}
struct EpiInA {
    const float* ss; const float* ssm; bf16_t* U; bf16_t* G;
    template <bool META> __device__ __forceinline__ void run(int row, int grp, int l32, f32x4 v) const {
        const float s = META ? ssm[row] : ss[row];
        const float rs = 1.0f / sqrtf(s * (1.0f / DM) + EPS);
        v = v * rs;
        int col = grp * 128 + 4 * l32;
        bf16_t* dst = (col < DM) ? U : G; col &= (DM - 1);
        u32x2 w; w.x = pk2(v[0], v[1]); w.y = pk2(v[2], v[3]);
        if (META) {
#pragma unroll
            for (int b = 0; b < NB; ++b) *(u32x2*)(dst + ((size_t)(b * TP + MPOS + row)) * DM + col) = w;
        } else *(u32x2*)(dst + (size_t)prow(row) * DM + col) = w;
    }
};
struct EpiOut {
    const float* base; float* out; float* xfm; bf16_t* XB; float* ssn; float* ssmn; int mode;
    template <bool META> __device__ __forceinline__ void run(int row, int grp, int l32, f32x4 v) const {
        const int col = grp * 128 + 4 * l32;
        const size_t pr = META ? (size_t)(MPOS + row) : (size_t)prow(row);
        f32x4 b;
        if (META) b = *(const f32x4*)(xfm + (size_t)row * DM + col);
        else if (mode == 0) b = *(const f32x4*)(base + (size_t)row * DM + col);
        else { const u32x2 w = *(const u32x2*)(XB + pr * DM + col); b = (f32x4){bflo(w.x), bfhi(w.x), bflo(w.y), bfhi(w.y)}; }
        const f32x4 x = b + v;
        if (META) *(f32x4*)(xfm + (size_t)row * DM + col) = x;
        if (mode == 2) { if (!META) *(f32x4*)(out + (size_t)row * DM + col) = x; }
        else {
            u32x2 w; w.x = pk2(x[0], x[1]); w.y = pk2(x[2], x[3]);
            if (META) __hip_atomic_store((unsigned long long*)(XB + pr * DM + col), ((unsigned long long)w.y << 32) | w.x, __ATOMIC_RELAXED, __HIP_MEMORY_SCOPE_AGENT);
            else *(u32x2*)(XB + pr * DM + col) = w;
            float q = (x[0] * x[0] + x[1] * x[1]) + (x[2] * x[2] + x[3] * x[3]);
            q = half_sum(q);
            if (l32 == 0) atomicAdd(META ? (ssmn + row) : (ssn + row), q);
        }
    }
};
struct EpiQKV {
    const float* ss; const float* ssm; const float* knorm; const float* qnorm; unsigned char* ws; int kind_off;
    template <bool META> __device__ __forceinline__ void run(int row, int grp, int l32, f32x4 v) const {
        const float s = META ? ssm[row] : ss[row];
        const float rs = 1.0f / sqrtf(s * (1.0f / DM) + EPS);
        v = v * rs;
        const int kind = kind_off + (grp >> 3), head = grp & 7;
        if (kind == 0 || kind == 2) {
            float q = (v[0] * v[0] + v[1] * v[1]) + (v[2] * v[2] + v[3] * v[3]);
            q = half_sum(q);
            const float inv = 1.0f / sqrtf(q * (1.0f / HD) + EPS);
            const f32x4 g = *(const f32x4*)((kind == 0 ? knorm : qnorm) + 4 * l32);
            v = v * inv * g;
        }
        if (kind == 3) {
#pragma unroll
            for (int i = 0; i < 4; ++i) v[i] = v[i] * sigmoidf_(v[i]);
        }
        const size_t boff = kind == 0 ? WS_K : (kind == 1 ? WS_V : (kind == 2 ? WS_U : WS_G));
        bf16_t* dst = (bf16_t*)(ws + boff);
        const int col = head * HD + 4 * l32;
        u32x2 w; w.x = pk2(v[0], v[1]); w.y = pk2(v[2], v[3]);
        if (META) {
#pragma unroll
            for (int b = 0; b < NB; ++b) *(u32x2*)(dst + ((size_t)(b * TP + MPOS + row)) * DM + col) = w;
        } else *(u32x2*)(dst + (size_t)prow(row) * DM + col) = w;
    }
};

template <class Epi>
__device__ __forceinline__ void naive_gemm_phase(LAS unsigned char* lds, const bf16_t* A, const bf16_t* Bt, int N, const Epi& E, int wv64_) {
    LAS float* As = (LAS float*)lds;
    LAS float* Bs = As + 32 * 33;
    const int tid = opaque_tid(), ty = tid >> 5, tx = tid & 31;
    const int ntn = N / 128, ntiles = (MROWS / 32) * ntn;
    for (int tile = blockIdx.x; tile < ntiles; tile += gridDim.x) {
        const int tm = tile / ntn, tn = tile % ntn;
        float acc[2][4];
#pragma unroll
        for (int i = 0; i < 2; ++i)
#pragma unroll
            for (int j = 0; j < 4; ++j) acc[i][j] = 0.f;
        const int ar = tid >> 4, ac = (tid & 15) * 2;
        const int bn = tid >> 2, bc = (tid & 3) * 8;
        const bf16_t* ap = A + (size_t)prow(tm * 32 + ar) * DM + ac;
        const bf16_t* bp = Bt + (size_t)(tn * 128 + bn) * DM + bc;
        for (int k0 = 0; k0 < DM; k0 += 32) {
            const unsigned aw = *(const unsigned*)(ap + k0);
            const u32x4 bw = *(const u32x4*)(bp + k0);
            __syncthreads();
            As[ar * 33 + ac] = bflo(aw); As[ar * 33 + ac + 1] = bfhi(aw);
            Bs[bn * 33 + bc + 0] = bflo(bw.x); Bs[bn * 33 + bc + 1] = bfhi(bw.x); Bs[bn * 33 + bc + 2] = bflo(bw.y); Bs[bn * 33 + bc + 3] = bfhi(bw.y);
            Bs[bn * 33 + bc + 4] = bflo(bw.z); Bs[bn * 33 + bc + 5] = bfhi(bw.z); Bs[bn * 33 + bc + 6] = bflo(bw.w); Bs[bn * 33 + bc + 7] = bfhi(bw.w);
            __syncthreads();
#pragma unroll 8
            for (int kk = 0; kk < 32; ++kk) {
                const float a0 = As[(2 * ty) * 33 + kk], a1 = As[(2 * ty + 1) * 33 + kk];
#pragma unroll
                for (int j = 0; j < 4; ++j) { const float b = Bs[(4 * tx + j) * 33 + kk]; acc[0][j] += a0 * b; acc[1][j] += a1 * b; }
            }
        }
#pragma unroll
        for (int i = 0; i < 2; ++i) E.template run<false>(tm * 32 + 2 * ty + i, tn, tx, (f32x4){acc[i][0], acc[i][1], acc[i][2], acc[i][3]});
    }
}

namespace pg8 {
constexpr int BM = 256, BK = 64, HALF = 128, HTB = HALF * BK * 2, STAGE_BYTES = 8 * HTB, NXCD = 8, WGM = 8;
__host__ __device__ __forceinline__ int lds_byte(int r, int c) { const int st = (r >> 4) * 2 + (c >> 5), rr = r & 15, cc = c & 31, ob = rr * 64 + cc * 2; return st * 1024 + (ob ^ (((ob >> 9) & 1) << 5)); }
__host__ __device__ __forceinline__ void stage_rc(int b, int& R, int& C) { const int st = b / 1024, sb = b % 1024, swz = sb ^ (((sb >> 9) & 1) << 5); R = (st >> 1) * 16 + swz / 64; C = (st & 1) * 32 + (swz % 64) / 2; }
__host__ __device__ __forceinline__ int perm32(int rho) { const int n = rho >> 4, i = rho & 15; return 8 * (i >> 2) + 4 * n + (i & 3); }
struct Unit { int pm, pn; };
struct Gemm { const bf16_t* A; const bf16_t* Bt; int M, N, K; };
struct StaticOrder {
    int nM, nN, nwg, G, c;
    __host__ __device__ void init(int M, int N, int G_, int c_) { nM = M / BM; nN = N / BM; nwg = nM * nN; G = G_; c = c_; }
    __host__ __device__ bool next(int i, Unit& u) const {
        const long L = (long)i * G + c; if (L >= nwg) return false;
        int wgid = (int)L; { const int q = nwg / NXCD, r = nwg % NXCD, xcd = wgid % NXCD, off = wgid / NXCD; wgid = (xcd < r ? xcd * (q + 1) : r * (q + 1) + (xcd - r) * q) + off; }
        const int nig = WGM * nN, gid = wgid / nig, fm = gid * WGM, gsz = (nM - fm) < WGM ? (nM - fm) : WGM;
        u.pm = fm + ((wgid % nig) % gsz); u.pn = (wgid % nig) / gsz; return true;
    }
    __device__ __forceinline__ void a_ready(const Unit&) const {}
    __device__ __forceinline__ void done(const Unit&) const {}
};
__device__ __forceinline__ unsigned cvt_pk_bf16(float lo, float hi) { unsigned r; asm volatile("v_cvt_pk_bf16_f32 %0, %1, %2" : "=v"(r) : "v"(lo), "v"(hi)); return r; }
__device__ __forceinline__ __amdgpu_buffer_rsrc_t act_rsrc(void* base) { return __builtin_amdgcn_make_buffer_rsrc(base, (short)0, (int)ACT_BYTES, 0x00020000); }
__device__ __forceinline__ void store16_wt(__amdgpu_buffer_rsrc_t rs, size_t byte_off, u32x4 w) { __builtin_amdgcn_raw_buffer_store_b128(w, rs, (unsigned)byte_off, 0, 16); }
__device__ __forceinline__ size_t a_tile_bytes(int pm, int K) { return (size_t)prow(pm * BM) * (size_t)K * 2; }

template <class Epi, class Sched, bool ALIGN_EPI = false, bool SP2 = false>
__device__ __forceinline__ void gemm_phase(LAS unsigned char* lds, const Gemm g, const Sched& S, const Epi& E, int wv64_) {
    const int tid = opaque_tid(), wid = __builtin_amdgcn_readfirstlane(tid >> 6), lane = tid & 63, wr = wid >> 2, wc = wid & 3, fr = lane & 15, fq = lane >> 4;
    const int K = g.K, nt = K / BK;
    unsigned voffA[2], voffB[2];
#pragma unroll
    for (int i = 0; i < 2; ++i) { int R, C; stage_rc(tid * 16 + i * 8192, R, C); const int Rb = Epi::PERM ? ((R & ~31) + perm32(R & 31)) : R;
        voffA[i] = (unsigned)(R * K + C) * 2u; voffB[i] = (unsigned)(Rb * K + C) * 2u; }
    const size_t kstep = (size_t)(BK * 2);
    const size_t hstep = (size_t)HALF * K * 2;
    const size_t tstep = 2 * hstep;
    const unsigned ldsw = (unsigned)wid * 1024u;
    const int aoff = lds_byte(wr * 64 + fr, fq * 8), boff = lds_byte(wc * 32 + fr, fq * 8);
#define PG8_SA(b, h) (((b) * 2 + (h)) * HTB)
#define PG8_SB(b, h) ((4 + (b) * 2 + (h)) * HTB)
#define PG8_STAGE(bufoff, gbase, voff) do { _Pragma("unroll") for (int _i = 0; _i < 2; ++_i) \
        __builtin_amdgcn_global_load_lds((const unsigned*)((const char*)(gbase) + (voff)[_i]), (LAS unsigned*)(lds + (bufoff) + ldsw + _i * 8192), 16, 0, 0); } while (0)
#define PG8_LDA(dst, b, h) do { _Pragma("unroll") for (int m = 0; m < 4; ++m) _Pragma("unroll") for (int k = 0; k < 2; ++k) dst[m][k] = *(const LAS bf16x8*)(lds + PG8_SA(b, h) + aoff + m * 2048 + k * 1024); } while (0)
#define PG8_LDB(dst, b, h) do { _Pragma("unroll") for (int n = 0; n < 2; ++n) _Pragma("unroll") for (int k = 0; k < 2; ++k) dst[n][k] = *(const LAS bf16x8*)(lds + PG8_SB(b, h) + boff + n * 2048 + k * 1024); } while (0)
#define PG8_MMA(ai, bj, At, Bt) do { __builtin_amdgcn_s_setprio(1); _Pragma("unroll") for (int m = 0; m < 4; ++m) _Pragma("unroll") for (int n = 0; n < 2; ++n) _Pragma("unroll") for (int k = 0; k < 2; ++k) \
        acc[ai][bj][m][n] = __builtin_amdgcn_mfma_f32_16x16x32_bf16(Bt[n][k], At[m][k], acc[ai][bj][m][n], 0, 0, 0); __builtin_amdgcn_s_setprio(0); } while (0)
#define PG8_WAIT_V(n) asm volatile("s_waitcnt vmcnt(" #n ")" ::: "memory")
#define PG8_WAIT_L(n) asm volatile("s_waitcnt lgkmcnt(" #n ")" ::: "memory")
#define PG8_BAR __builtin_amdgcn_s_barrier()
#define PG8_SCHED __builtin_amdgcn_sched_barrier(0)
    Unit cur, nxt; int ui = 0;
    if (!S.next(0, cur)) return;
    f32x4 acc[2][2][4][2];
#pragma unroll
    for (int a = 0; a < 2; ++a)
#pragma unroll
        for (int b = 0; b < 2; ++b)
#pragma unroll
            for (int m = 0; m < 4; ++m)
#pragma unroll
                for (int n = 0; n < 2; ++n) acc[a][b][m][n] = (f32x4){0.f, 0.f, 0.f, 0.f};
    bf16x8 At[4][2], B0[2][2], B1[2][2];
    const char* cA = (const char*)g.A + a_tile_bytes(cur.pm, K); const char* cB = (const char*)g.Bt + (size_t)cur.pn * tstep;
    S.a_ready(cur);
    if constexpr (SP2) {
        PG8_STAGE(PG8_SB(0, 0), cB, voffB); PG8_STAGE(PG8_SB(0, 1), cB + hstep, voffB); PG8_STAGE(PG8_SA(0, 0), cA, voffA); PG8_STAGE(PG8_SA(0, 1), cA + hstep, voffA);
        if (wr == 1) PG8_BAR;
        PG8_WAIT_V(2); PG8_BAR;
        PG8_STAGE(PG8_SB(1, 0), cB + kstep, voffB); PG8_STAGE(PG8_SA(1, 0), cA + kstep, voffA); PG8_STAGE(PG8_SB(1, 1), cB + hstep + kstep, voffB);
        PG8_WAIT_V(6); PG8_BAR;
    } else {
        PG8_STAGE(PG8_SB(0, 0), cB, voffB); PG8_STAGE(PG8_SA(0, 0), cA, voffA); PG8_STAGE(PG8_SB(0, 1), cB + hstep, voffB); PG8_STAGE(PG8_SA(0, 1), cA + hstep, voffA);
        if (wr == 1) PG8_BAR;
        PG8_WAIT_V(4); PG8_BAR;
        PG8_STAGE(PG8_SB(1, 0), cB + kstep, voffB); PG8_STAGE(PG8_SA(1, 0), cA + kstep, voffA); PG8_STAGE(PG8_SB(1, 1), cB + hstep + kstep, voffB);
        PG8_WAIT_V(6); PG8_BAR;
    }
    for (;;) {
        const bool has_next = S.next(ui + 1, nxt);
        const char* nA = has_next ? (const char*)g.A + a_tile_bytes(nxt.pm, K) : cA; const char* nB = has_next ? (const char*)g.Bt + (size_t)nxt.pn * tstep : cB;
        for (int t = 0; t < nt; t += 2) {
            const bool last = (t == nt - 2);
            const char* a1 = cA + (size_t)(t + 1) * kstep;
            const char* a2 = last ? nA : cA + (size_t)(t + 2) * kstep; const char* b2 = last ? nB : cB + (size_t)(t + 2) * kstep;
            const char* a3 = a2 + kstep; const char* b3 = b2 + kstep;
            if (last && has_next) S.a_ready(nxt);
            if constexpr (SP2) {
            PG8_LDB(B0, 0, 0); PG8_LDB(B1, 0, 1); PG8_SCHED; PG8_LDA(At, 0, 0); PG8_STAGE(PG8_SA(1, 1), a1 + hstep, voffA);
            PG8_WAIT_V(8); PG8_WAIT_L(0); PG8_BAR; PG8_MMA(0, 0, At, B0); PG8_MMA(0, 1, At, B1); PG8_BAR; PG8_SCHED;
            PG8_LDA(At, 0, 1); PG8_STAGE(PG8_SB(0, 0), b2, voffB); PG8_STAGE(PG8_SB(0, 1), b2 + hstep, voffB); PG8_STAGE(PG8_SA(0, 0), a2, voffA);
            PG8_WAIT_V(8); PG8_WAIT_L(0); PG8_BAR; PG8_MMA(1, 0, At, B0); PG8_MMA(1, 1, At, B1); PG8_BAR; PG8_SCHED;
            PG8_LDB(B0, 1, 0); PG8_LDB(B1, 1, 1); PG8_SCHED; PG8_LDA(At, 1, 0); PG8_STAGE(PG8_SA(0, 1), a2 + hstep, voffA);
            PG8_WAIT_V(8); PG8_WAIT_L(0); PG8_BAR; PG8_MMA(0, 0, At, B0); PG8_MMA(0, 1, At, B1); PG8_BAR; PG8_SCHED;
            PG8_LDA(At, 1, 1); PG8_STAGE(PG8_SB(1, 0), b3, voffB); PG8_STAGE(PG8_SB(1, 1), b3 + hstep, voffB); PG8_STAGE(PG8_SA(1, 0), a3, voffA);
            PG8_WAIT_V(8); PG8_WAIT_L(0); PG8_BAR; PG8_MMA(1, 0, At, B0); PG8_MMA(1, 1, At, B1); PG8_BAR; PG8_SCHED;
            } else {
            PG8_LDB(B0, 0, 0); PG8_SCHED; PG8_LDA(At, 0, 0); PG8_STAGE(PG8_SA(1, 1), a1 + hstep, voffA);
            PG8_WAIT_L(8); PG8_BAR; PG8_WAIT_L(0); PG8_MMA(0, 0, At, B0); PG8_BAR; PG8_SCHED;
            PG8_LDB(B1, 0, 1); PG8_STAGE(PG8_SB(0, 0), b2, voffB);
            PG8_BAR; PG8_WAIT_L(0); PG8_MMA(0, 1, At, B1); PG8_BAR;
            PG8_LDA(At, 0, 1); PG8_STAGE(PG8_SA(0, 0), a2, voffA);
            PG8_BAR; PG8_WAIT_L(0); PG8_MMA(1, 0, At, B0); PG8_BAR; PG8_SCHED;
            PG8_STAGE(PG8_SB(0, 1), b2 + hstep, voffB);
            PG8_WAIT_V(6); PG8_BAR; PG8_MMA(1, 1, At, B1); PG8_BAR;
            PG8_LDB(B0, 1, 0); PG8_SCHED; PG8_LDA(At, 1, 0); PG8_STAGE(PG8_SA(0, 1), a2 + hstep, voffA);
            PG8_WAIT_L(8); PG8_BAR; PG8_WAIT_L(0); PG8_MMA(0, 0, At, B0); PG8_BAR; PG8_SCHED;
            PG8_LDB(B1, 1, 1); PG8_STAGE(PG8_SB(1, 0), b3, voffB);
            PG8_BAR; PG8_WAIT_L(0); PG8_MMA(0, 1, At, B1); PG8_BAR;
            PG8_LDA(At, 1, 1); PG8_STAGE(PG8_SA(1, 0), a3, voffA);
            PG8_BAR; PG8_WAIT_L(0); PG8_MMA(1, 0, At, B0); PG8_BAR; PG8_SCHED;
            PG8_STAGE(PG8_SB(1, 1), b3 + hstep, voffB);
            PG8_WAIT_V(6); PG8_BAR; PG8_MMA(1, 1, At, B1); PG8_BAR;
            }
        }
        if constexpr (ALIGN_EPI) { if (wr == 0) PG8_BAR; }
        E(acc, cur, wr, wc, fr, fq); S.done(cur);
        if (!has_next) break;
#pragma unroll
        for (int a = 0; a < 2; ++a)
#pragma unroll
            for (int b = 0; b < 2; ++b)
#pragma unroll
                for (int m = 0; m < 4; ++m)
#pragma unroll
                    for (int n = 0; n < 2; ++n) acc[a][b][m][n] = (f32x4){0.f, 0.f, 0.f, 0.f};
        cur = nxt; cA = nA; cB = nB; ++ui;
        if constexpr (ALIGN_EPI) { if (wr == 1) PG8_BAR; }
    }
    PG8_WAIT_V(0);
    if constexpr (!ALIGN_EPI) { if (wr == 0) PG8_BAR; }
    PG8_BAR;
#undef PG8_SA
#undef PG8_SB
#undef PG8_STAGE
#undef PG8_LDA
#undef PG8_LDB
#undef PG8_MMA
#undef PG8_WAIT_V
#undef PG8_WAIT_L
#undef PG8_BAR
#undef PG8_SCHED
}

struct FastInA {
    static constexpr bool PERM = true;
    const float* ss; unsigned char* ws;
    __device__ __forceinline__ void operator()(const f32x4 (&acc)[2][2][4][2], const Unit& u, int wr, int wc, int fr, int fq) const {
        const int r0 = u.pm * BM + wr * 64 + fr;
        const size_t pr0 = (size_t)prow(u.pm * BM) + wr * 64 + fr;
        bf16_t* dst = (bf16_t*)(ws + (u.pn < 4 ? WS_U : WS_G));
        const int col0 = (u.pn & 3) * BM + wc * 32 + 8 * fq;
        float ssv[2][4];
#pragma unroll
        for (int ai = 0; ai < 2; ++ai)
#pragma unroll
            for (int m = 0; m < 4; ++m) ssv[ai][m] = ss[r0 + ai * HALF + m * 16];
        asm volatile("" ::: "memory");
#pragma unroll
        for (int ai = 0; ai < 2; ++ai)
#pragma unroll
            for (int m = 0; m < 4; ++m) {
                const float rs = __builtin_amdgcn_rsqf(ssv[ai][m] * (1.0f / DM) + EPS);
                bf16_t* rowp = dst + (pr0 + ai * HALF + m * 16) * DM + col0;
#pragma unroll
                for (int bj = 0; bj < 2; ++bj) { const f32x4 v0 = acc[ai][bj][m][0] * rs, v1 = acc[ai][bj][m][1] * rs;
                    u32x4 w; w.x = cvt_pk_bf16(v0[0], v0[1]); w.y = cvt_pk_bf16(v0[2], v0[3]); w.z = cvt_pk_bf16(v1[0], v1[1]); w.w = cvt_pk_bf16(v1[2], v1[3]);
                    *(u32x4*)(rowp + bj * HALF) = w; }
            }
    }
};
struct FastOut {
    static constexpr bool PERM = true;
    const float* base; float* out; bf16_t* XB; float* ssn; int mode;
    template <int MODE> __device__ __forceinline__ float piece(const f32x4 b0, const f32x4 b1, const f32x4 a0, const f32x4 a1, size_t off, size_t xb_byte, const __amdgpu_buffer_rsrc_t xbr) const {
        const f32x4 x0 = b0 + a0, x1 = b1 + a1;
        if constexpr (MODE == 2) { *(f32x4*)(out + off) = x0; *(f32x4*)(out + off + 4) = x1; return 0.f; }
        else {
            u32x4 w; w.x = cvt_pk_bf16(x0[0], x0[1]); w.y = cvt_pk_bf16(x0[2], x0[3]); w.z = cvt_pk_bf16(x1[0], x1[1]); w.w = cvt_pk_bf16(x1[2], x1[3]);
            store16_wt(xbr, xb_byte, w);
            return (x0[0] * x0[0] + x0[1] * x0[1]) + (x0[2] * x0[2] + x0[3] * x0[3]) + (x1[0] * x1[0] + x1[1] * x1[1]) + (x1[2] * x1[2] + x1[3] * x1[3]);
        }
    }
    template <int MODE> __device__ __forceinline__ void run(const f32x4 (&acc)[2][2][4][2], const Unit& u, int wr, int wc, int fr, int fq) const {
        const int r0 = u.pm * BM + wr * 64 + fr;
        const size_t pr0 = (size_t)prow(u.pm * BM) + wr * 64 + fr;
        const int col0 = u.pn * BM + wc * 32 + 8 * fq;
        const __amdgpu_buffer_rsrc_t xbr = act_rsrc(XB);
        if constexpr (MODE != 0) {
            u32x4 res[2][4][2];
#pragma unroll
            for (int ai = 0; ai < 2; ++ai)
#pragma unroll
                for (int m = 0; m < 4; ++m)
#pragma unroll
                    for (int bj = 0; bj < 2; ++bj) res[ai][m][bj] = *(const u32x4*)(XB + (pr0 + ai * HALF + m * 16) * DM + col0 + bj * HALF);
            asm volatile("" ::: "memory");
#pragma unroll
            for (int ai = 0; ai < 2; ++ai)
#pragma unroll
                for (int m = 0; m < 4; ++m) {
                    const int r = r0 + ai * HALF + m * 16;
                    float q = 0.f;
#pragma unroll
                    for (int bj = 0; bj < 2; ++bj) { const u32x4 w = res[ai][m][bj];
                        q += piece<MODE>((f32x4){bflo(w.x), bfhi(w.x), bflo(w.y), bfhi(w.y)}, (f32x4){bflo(w.z), bfhi(w.z), bflo(w.w), bfhi(w.w)}, acc[ai][bj][m][0], acc[ai][bj][m][1],
                                         (size_t)r * DM + col0 + bj * HALF, ((pr0 + ai * HALF + m * 16) * DM + col0 + bj * HALF) * 2, xbr); }
                    if constexpr (MODE != 2) { q += __shfl_xor(q, 16); q += __shfl_xor(q, 32); if (fq == 0) atomicAdd(ssn + r, q); }
                }
        } else {
            f32x4 rbuf[2][2][2][2];
#define FO_LOAD(slot, ai, mp) do { _Pragma("unroll") for (int mm_ = 0; mm_ < 2; ++mm_) _Pragma("unroll") for (int bj_ = 0; bj_ < 2; ++bj_) { \
                const size_t off_ = (size_t)(r0 + (ai) * HALF + (2 * (mp) + mm_) * 16) * DM + col0 + bj_ * HALF; \
                rbuf[slot][mm_][bj_][0] = *(const f32x4*)(base + off_); rbuf[slot][mm_][bj_][1] = *(const f32x4*)(base + off_ + 4); } } while (0)
#define FO_PROC(slot, ai, mp) do { _Pragma("unroll") for (int mm_ = 0; mm_ < 2; ++mm_) { const int m_ = 2 * (mp) + mm_; const int r_ = r0 + (ai) * HALF + m_ * 16; float q_ = 0.f; \
                _Pragma("unroll") for (int bj_ = 0; bj_ < 2; ++bj_) q_ += piece<0>(rbuf[slot][mm_][bj_][0], rbuf[slot][mm_][bj_][1], acc[ai][bj_][m_][0], acc[ai][bj_][m_][1], \
                    (size_t)r_ * DM + col0 + bj_ * HALF, ((pr0 + (ai) * HALF + m_ * 16) * DM + col0 + bj_ * HALF) * 2, xbr); \
                q_ += __shfl_xor(q_, 16); q_ += __shfl_xor(q_, 32); if (fq == 0) atomicAdd(ssn + r_, q_); } } while (0)
#define FO_CB() asm volatile("" ::: "memory")
            FO_LOAD(0, 0, 0); FO_LOAD(1, 0, 1); FO_CB();
            FO_PROC(0, 0, 0); FO_CB(); FO_LOAD(0, 1, 0); FO_CB();
            FO_PROC(1, 0, 1); FO_CB(); FO_LOAD(1, 1, 1); FO_CB();
            FO_PROC(0, 1, 0); FO_CB();
            FO_PROC(1, 1, 1);
#undef FO_LOAD
#undef FO_PROC
#undef FO_CB
        }
    }
    __device__ __forceinline__ void operator()(const f32x4 (&acc)[2][2][4][2], const Unit& u, int wr, int wc, int fr, int fq) const {
        if (mode == 0) run<0>(acc, u, wr, wc, fr, fq); else if (mode == 1) run<1>(acc, u, wr, wc, fr, fq); else run<2>(acc, u, wr, wc, fr, fq);
    }
};
struct NullEpi {
    static constexpr bool PERM = true;
    __device__ __forceinline__ void operator()(const f32x4 (&acc)[2][2][4][2], const Unit&, int, int, int, int) const {
#pragma unroll
        for (int ai = 0; ai < 2; ++ai)
#pragma unroll
            for (int bj = 0; bj < 2; ++bj)
#pragma unroll
                for (int m = 0; m < 4; ++m) { asm volatile("" :: "v"(acc[ai][bj][m][0]), "v"(acc[ai][bj][m][1])); }
    }
};
struct FastQKV {
    static constexpr bool PERM = true;
    const float* ss; const float* knorm; const float* qnorm; unsigned char* ws; LAS float* P; int kind_off;
    __device__ __forceinline__ void operator()(const f32x4 (&acc)[2][2][4][2], const Unit& u, int wr, int wc, int fr, int fq) const {
        const int kind = kind_off + (u.pn >> 2);
        const int r0 = u.pm * BM + wr * 64 + fr;
        const size_t pr0 = (size_t)prow(u.pm * BM) + wr * 64 + fr;
        const size_t boff = kind == 0 ? WS_K : (kind == 1 ? WS_V : (kind == 2 ? WS_U : WS_G));
        bf16_t* dst = (bf16_t*)(ws + boff);
        const int col0 = (u.pn & 3) * BM + wc * 32 + 8 * fq;
        const bool nrm = (kind == 0 || kind == 2);
        f32x4 g0 = (f32x4){1.f, 1.f, 1.f, 1.f}, g1 = g0;
        float ssv[2][4];
#pragma unroll
        for (int ai = 0; ai < 2; ++ai)
#pragma unroll
            for (int m = 0; m < 4; ++m) ssv[ai][m] = ss[r0 + ai * HALF + m * 16];
        if (nrm) {
            const float* gp = (kind == 0 ? knorm : qnorm) + wc * 32 + 8 * fq;
            g0 = *(const f32x4*)gp; g1 = *(const f32x4*)(gp + 4);
#pragma unroll
            for (int ai = 0; ai < 2; ++ai)
#pragma unroll
                for (int m = 0; m < 4; ++m) {
                    const float rs2 = __builtin_amdgcn_rcpf(ssv[ai][m] * (1.0f / DM) + EPS);
#pragma unroll
                    for (int bj = 0; bj < 2; ++bj) { const f32x4 a0 = acc[ai][bj][m][0], a1 = acc[ai][bj][m][1];
                        float q = (a0[0] * a0[0] + a0[1] * a0[1]) + (a0[2] * a0[2] + a0[3] * a0[3]) + (a1[0] * a1[0] + a1[1] * a1[1]) + (a1[2] * a1[2] + a1[3] * a1[3]);
                        q += __shfl_xor(q, 16); q += __shfl_xor(q, 32);
                        if (fq == 0) P[((ai * HALF + wr * 64 + m * 16 + fr) * 2 + bj) * 4 + wc] = q * rs2; }
                }
            asm volatile("s_waitcnt lgkmcnt(0)" ::: "memory"); __builtin_amdgcn_s_barrier(); asm volatile("" ::: "memory");
        }
        asm volatile("" ::: "memory");
#pragma unroll
        for (int ai = 0; ai < 2; ++ai)
#pragma unroll
            for (int m = 0; m < 4; ++m) {
                const float rs = __builtin_amdgcn_rsqf(ssv[ai][m] * (1.0f / DM) + EPS);
                bf16_t* rowp = dst + (pr0 + ai * HALF + m * 16) * DM + col0;
#pragma unroll
                for (int bj = 0; bj < 2; ++bj) {
                    float sc = rs;
                    if (nrm) { const f32x4 p4 = *(const LAS f32x4*)(P + ((ai * HALF + wr * 64 + m * 16 + fr) * 2 + bj) * 4);
                        sc = rs * __builtin_amdgcn_rsqf(((p4[0] + p4[1]) + (p4[2] + p4[3])) * (1.0f / HD) + EPS); }
                    f32x4 v0 = acc[ai][bj][m][0] * sc * g0, v1 = acc[ai][bj][m][1] * sc * g1;
                    if (kind == 3) {
#pragma unroll
                        for (int i = 0; i < 4; ++i) { v0[i] = v0[i] * sigmoidf_(v0[i]); v1[i] = v1[i] * sigmoidf_(v1[i]); } }
                    u32x4 w; w.x = cvt_pk_bf16(v0[0], v0[1]); w.y = cvt_pk_bf16(v0[2], v0[3]); w.z = cvt_pk_bf16(v1[0], v1[1]); w.w = cvt_pk_bf16(v1[2], v1[3]);
                    *(u32x4*)(rowp + bj * HALF) = w; }
            }
    }
};
}

template <class Epi>
__device__ __forceinline__ void meta_gemm_job(LAS unsigned char* lds, const bf16_t* A16, const bf16_t* Bt, int grp, const Epi& E, int wv64_) {
    const int tid = opaque_tid(), lane = tid & 63, w = __builtin_amdgcn_readfirstlane(tid >> 6);
    const int fr = lane & 15, fq = lane >> 4;
    f32x4 acc[8];
#pragma unroll
    for (int f = 0; f < 8; ++f) acc[f] = (f32x4){0.f, 0.f, 0.f, 0.f};
    {
        bf16x8 af[4], bfr[4][8];
#pragma unroll
        for (int ks = 0; ks < 4; ++ks) {
            const int k = 128 * w + 32 * ks + 8 * fq;
            af[ks] = *(const bf16x8*)(A16 + (size_t)fr * DM + k);
#pragma unroll
            for (int f = 0; f < 8; ++f) bfr[ks][f] = *(const bf16x8*)(Bt + (size_t)(grp * 128 + 16 * f + fr) * DM + k);
        }
#pragma unroll
        for (int ks = 0; ks < 4; ++ks) { asm volatile("" : "+v"(af[ks]) :: "memory");
#pragma unroll
            for (int f = 0; f < 8; ++f) asm volatile("" : "+v"(bfr[ks][f]) :: "memory"); }
#pragma unroll
        for (int ks = 0; ks < 4; ++ks)
#pragma unroll
            for (int f = 0; f < 8; ++f) acc[f] = __builtin_amdgcn_mfma_f32_16x16x32_bf16(af[ks], bfr[ks][f], acc[f], 0, 0, 0);
    }
    LAS float* P = (LAS float*)lds;
    __syncthreads();
#pragma unroll
    for (int f = 0; f < 8; ++f)
#pragma unroll
        for (int r = 0; r < 4; ++r) P[(w * 16 + 4 * fq + r) * 128 + 16 * f + fr] = acc[f][r];
    __syncthreads();
    const int row = tid >> 5, l32 = tid & 31;
    f32x4 v = (f32x4){0.f, 0.f, 0.f, 0.f};
#pragma unroll
    for (int ww = 0; ww < 8; ++ww) v += *(const LAS f32x4*)(P + (ww * 16 + row) * 128 + 4 * l32);
    __syncthreads();
    E.template run<true>(row, grp, l32, v);
}

__device__ __forceinline__ void prep_transpose_item(const float* W, int ldw, int col0, const float* g, int K, bf16_t* WT, int row_off, LAS float* scr, int kb, int nb, int lane) {
    const int k0 = 64 * kb, n0 = 32 * nb;
    f32x4 xv[8]; float gs[8];
#pragma unroll
    for (int i = 0; i < 8; ++i) { const int kk = 8 * i + (lane >> 3), n4 = 4 * (lane & 7);
        xv[i] = *(const f32x4*)(W + (size_t)(k0 + kk) * ldw + col0 + n0 + n4); gs[i] = g ? g[k0 + kk] : 1.0f; }
#pragma unroll
    for (int i = 0; i < 8; ++i) asm volatile("" : "+v"(xv[i]), "+v"(gs[i]) :: "memory");
#pragma unroll
    for (int i = 0; i < 8; ++i) { const int kk = 8 * i + (lane >> 3), n4 = 4 * (lane & 7);
        const f32x4 x = xv[i] * gs[i];
        scr[kk * 33 + n4] = x[0]; scr[kk * 33 + n4 + 1] = x[1]; scr[kk * 33 + n4 + 2] = x[2]; scr[kk * 33 + n4 + 3] = x[3]; }
    LDS_WAIT(); asm volatile("" ::: "memory");
    const int c = lane & 7;
#pragma unroll
    for (int j = 0; j < 4; ++j) { const int n = (lane >> 3) + 8 * j; const LAS float* s = scr + (8 * c) * 33 + n;
        u32x4 o; o.x = pk2(s[0 * 33], s[1 * 33]); o.y = pk2(s[2 * 33], s[3 * 33]); o.z = pk2(s[4 * 33], s[5 * 33]); o.w = pk2(s[6 * 33], s[7 * 33]);
        *(u32x4*)(WT + (size_t)(row_off + n0 + n) * K + k0 + 8 * c) = o; }
    LDS_WAIT(); asm volatile("" ::: "memory");
}
__device__ __forceinline__ float row_to_bf16(const float* xrow, bf16_t* orow, float* fcopy, int lane) {
    const f32x4* xr = (const f32x4*)xrow + lane;
    f32x4 v[4]; float s = 0.f;
#pragma unroll
    for (int j = 0; j < 4; ++j) { v[j] = xr[64 * j]; s += (v[j][0] * v[j][0] + v[j][1] * v[j][1]) + (v[j][2] * v[j][2] + v[j][3] * v[j][3]); }
    u32x2* o8 = (u32x2*)orow + lane;
#pragma unroll
    for (int j = 0; j < 4; ++j) { u32x2 w; w.x = pk2(v[j][0], v[j][1]); w.y = pk2(v[j][2], v[j][3]); o8[64 * j] = w; }
    if (fcopy) {
#pragma unroll
        for (int j = 0; j < 4; ++j) ((f32x4*)fcopy + lane)[64 * j] = v[j];
    }
    return wave_sum(s);
}
__device__ __forceinline__ void prep_phase(LAS unsigned char* lds, const Args& a, int wv64_) {
    const int tid = opaque_tid(), lane = tid & 63, wave = __builtin_amdgcn_readfirstlane(tid >> 6);
    const int gw = blockIdx.x * NWAVES + wave, NGW = gridDim.x * NWAVES;
    unsigned char* ws = a.ws;
    LAS float* scr = (LAS float*)(lds + wave * 16384);
    constexpr int I_BIG = (DM / 64) * (2048 / 32);
    constexpr int I_SQ = (DM / 64) * (DM / 32);
    constexpr int I_BLK = (256 / 64) * (256 / 32);
    constexpr int PER_A = I_BIG + I_SQ + 8 * I_BLK;
    constexpr int NITEMS = 2 * PER_A + I_BIG   + I_BIG   + I_BIG   + 2 * I_SQ;
    for (int it = gw; it < NITEMS; it += NGW) {
        int r = it;
        if (r < 2 * PER_A) {
            const int l = r / PER_A; r -= l * PER_A;
            unsigned char* wb = ws + WS_WA + (size_t)l * WA_STRIDE;
            if (r < I_BIG) { prep_transpose_item(a.in[I_AWIN] + (size_t)l * DM * 2048, 2048, 0, a.in[I_ANORM] + l * DM, DM, (bf16_t*)wb, 0, scr, r / 64, r % 64, lane); continue; } r -= I_BIG;
            if (r < I_SQ) { prep_transpose_item(a.in[I_AWOUT] + (size_t)l * DM * DM, DM, 0, nullptr, DM, (bf16_t*)(wb + WA_WOUT), 0, scr, r / 32, r % 32, lane); continue; } r -= I_SQ;
            const int which = r / (4 * I_BLK); r -= which * 4 * I_BLK;
            const int n = r / I_BLK; r -= n * I_BLK;
            const float* W = a.in[which ? I_AWI : I_AWR] + ((size_t)(l * 4 + n)) * 65536;
            prep_transpose_item(W, 256, 0, nullptr, 256, (bf16_t*)(wb + (which ? WA_WI : WA_WR)) + (size_t)n * 65536, 0, scr, r / 8, r % 8, lane); continue;
        }
        r -= 2 * PER_A;
        if (r < I_BIG) { prep_transpose_item(a.in[I_WKV], 2056, 0, a.in[I_KVNORM], DM, (bf16_t*)(ws + WS_WKVQ), 0, scr, r / 64, r % 64, lane); continue; } r -= I_BIG;
        if (r < I_BIG) { prep_transpose_item(a.in[I_BWIN], 2048, 0, a.in[I_BNORM], DM, (bf16_t*)(ws + WS_WKVQ), 2048, scr, r / 64, r % 64, lane); continue; } r -= I_BIG;
        if (r < I_BIG) { prep_transpose_item(a.in[I_BWIN] + (size_t)DM * 2048, 2048, 0, a.in[I_BNORM] + DM, DM, (bf16_t*)(ws + WS_WINB1), 0, scr, r / 64, r % 64, lane); continue; } r -= I_BIG;
        const int j = r / I_SQ; r -= j * I_SQ;
        prep_transpose_item(a.in[I_BWOUT] + (size_t)j * DM * DM, DM, 0, nullptr, DM, (bf16_t*)(ws + WS_WOUTB) + (size_t)j * DM * DM, 0, scr, r / 32, r % 32, lane);
    }
    {
        bf16_t* wf = (bf16_t*)(ws + WS_WF);
        for (int i = blockIdx.x * NTHREADS + tid; i < 16 * DM; i += gridDim.x * NTHREADS) {
            const int h = i >> 10, k = i & 1023;
            wf[i] = (bf16_t)(h < 8 ? f2bf(a.in[I_KVNORM][k] * a.in[I_WKV][(size_t)k * 2056 + 2048 + h]) : 0u);
        }
    }
    float* ss0 = (float*)(ws + WS_CTL + CTL_SS);
    float* ssm0 = (float*)(ws + WS_CTL + CTL_SSM);
    bf16_t* XB = (bf16_t*)(ws + WS_XB);
    if (gw < MROWS) {
        f32x4 cur[4], nxt[4];
#pragma unroll
        for (int j = 0; j < 4; ++j) cur[j] = ((const f32x4*)(a.in[I_X] + (size_t)gw * DM) + lane)[64 * j];
        for (int m = gw; m < MROWS; m += NGW) {
            const int mn = (m + NGW < MROWS) ? m + NGW : m;
#pragma unroll
            for (int j = 0; j < 4; ++j) nxt[j] = ((const f32x4*)(a.in[I_X] + (size_t)mn * DM) + lane)[64 * j];
            asm volatile("" ::: "memory");
            float sq = 0.f;
            u32x2* o8 = (u32x2*)(XB + (size_t)prow(m) * DM) + lane;
#pragma unroll
            for (int j = 0; j < 4; ++j) { const f32x4 v = cur[j]; sq += (v[0] * v[0] + v[1] * v[1]) + (v[2] * v[2] + v[3] * v[3]);
                u32x2 w; w.x = pk2(v[0], v[1]); w.y = pk2(v[2], v[3]); o8[64 * j] = w; }
            sq = wave_sum(sq); if (lane == 0) ss0[m] = sq;
            asm volatile("" ::: "memory");
#pragma unroll
            for (int j = 0; j < 4; ++j) cur[j] = nxt[j];
        }
    }
    for (int i = gw; i < NMETA; i += NGW) { const float s = row_to_bf16(a.in[I_META] + (size_t)i * DM, XB + (size_t)(MPOS + i) * DM, (float*)(ws + WS_XFM) + (size_t)i * DM, lane); if (lane == 0) ssm0[i] = s; }
    {
        static_assert(WS_G == WS_U + ACT_BYTES && WS_YG == WS_G + ACT_BYTES && WS_K == WS_YG + ACT_BYTES && WS_V == WS_K + ACT_BYTES, "contiguous activation buffers");
        for (int r = gw; r < 5 * NB * MPOS; r += NGW) {
            const int bi = r / (NB * MPOS), rr = r % (NB * MPOS), b = rr / MPOS, p = rr % MPOS;
            u32x4* o = (u32x4*)((bf16_t*)(ws + WS_U + (size_t)bi * ACT_BYTES) + (size_t)(b * TP + p) * DM) + lane;
            o[0] = (u32x4){0u, 0u, 0u, 0u}; o[64] = (u32x4){0u, 0u, 0u, 0u};
        }
        float* LS = (float*)(ws + WS_LS);
        for (int i = blockIdx.x * NTHREADS + tid; i < NB * NH * MPOS; i += gridDim.x * NTHREADS) LS[(size_t)(i / MPOS) * TP + (i % MPOS)] = 0.f;
    }
}

__device__ __forceinline__ void scan_phase_simple(LAS unsigned char* lds, const Args& a, int layer, int wv64_) {
    const int tid = opaque_tid();
    unsigned char* ws = a.ws;
    const bf16_t* U = (const bf16_t*)(ws + WS_U); const bf16_t* G = (const bf16_t*)(ws + WS_G); bf16_t* YG = (bf16_t*)(ws + WS_YG);
    LAS float* Wl = (LAS float*)lds;
    LAS float* UC = Wl + 256 * 64;
    LAS float* AB = UC + 32 * 257 + 32;
    for (int unit = blockIdx.x; unit < 256; unit += gridDim.x) {
        const int b = unit & 7, j = unit >> 3, ch0 = 32 * j, blk = j >> 3, kc0 = 256 * blk, oc0 = 32 * (j & 7);
        __syncthreads();
        {
            const float* wr = a.in[I_AWR] + ((size_t)(layer * 4 + blk)) * 65536;
            const float* wi = a.in[I_AWI] + ((size_t)(layer * 4 + blk)) * 65536;
            for (int idx = tid; idx < 256 * 64; idx += NTHREADS) { const int k = idx >> 6, c = idx & 63; Wl[idx] = (c < 32 ? wr : wi)[k * 256 + oc0 + (c & 31)]; }
        }
        const int crow = tid >> 5, cch = (tid & 31) * 8;
        float cw[4][8], cb[8];
#pragma unroll
        for (int i = 0; i < 8; ++i) { cb[i] = a.in[I_ACONVB][layer * DM + kc0 + cch + i];
#pragma unroll
            for (int k = 0; k < 4; ++k) cw[k][i] = a.in[I_ACONVW][(size_t)layer * 4 * DM + k * DM + kc0 + cch + i]; }
        const int grow = tid >> 4, gc = (tid & 15) * 2;
        float br[2], bi[2], L8[2];
#pragma unroll
        for (int e = 0; e < 2; ++e) { const int c = layer * DM + ch0 + gc + e; br[e] = a.in[I_ABR][c]; bi[e] = a.in[I_ABI][c];
            const float lam = a.in[I_ALAM][c]; const float sp = (lam < 0.f ? -lam : 0.f) + log1pf(__expf(-fabsf(lam)));
            L8[e] = -8.0f * sp; }
        float hstate = 0.f;
        for (int tile = 0; tile < TP / 32; ++tile) {
            const int r0 = tile * 32;
#pragma unroll
            for (int h2 = 0; h2 < 2; ++h2) {
                const int rr = crow + 16 * h2, p = r0 + rr;
                float acc[8];
#pragma unroll
                for (int i = 0; i < 8; ++i) acc[i] = cb[i];
#pragma unroll
                for (int k = 0; k < 4; ++k) { const int q = p - 3 + k;
                    if (q >= 0) { const u32x4 w = *(const u32x4*)(U + (size_t)(b * TP + q) * DM + kc0 + cch);
                        acc[0] += cw[k][0] * bflo(w.x); acc[1] += cw[k][1] * bfhi(w.x); acc[2] += cw[k][2] * bflo(w.y); acc[3] += cw[k][3] * bfhi(w.y);
                        acc[4] += cw[k][4] * bflo(w.z); acc[5] += cw[k][5] * bfhi(w.z); acc[6] += cw[k][6] * bflo(w.w); acc[7] += cw[k][7] * bfhi(w.w); } }
#pragma unroll
                for (int i = 0; i < 8; ++i) UC[rr * 257 + cch + i] = acc[i];
            }
            __syncthreads();
            {
                const int p = r0 + grow;
                float ar[2] = {0.f, 0.f}, ai[2] = {0.f, 0.f};
#pragma unroll 8
                for (int k = 0; k < 256; ++k) { const float u = UC[grow * 257 + k];
                    ar[0] += u * Wl[k * 64 + gc]; ar[1] += u * Wl[k * 64 + gc + 1]; ai[0] += u * Wl[k * 64 + 32 + gc]; ai[1] += u * Wl[k * 64 + 32 + gc + 1]; }
#pragma unroll
                for (int e = 0; e < 2; ++e) {
                    const float r = sigmoidf_(ar[e] + br[e]), ig = sigmoidf_(ai[e] + bi[e]);
                    const float la = r * L8[e];
                    const float av = __expf(la);
                    const float mult = sqrtf(fmaxf(-expm1f(2.0f * la), 0.f));
                    const float uu = UC[grow * 257 + oc0 + gc + e];
                    float bv = mult * ig * uu; if (p < MPOS) bv = 0.f;
                    AB[grow * 32 + gc + e] = av; AB[1024 + grow * 32 + gc + e] = bv;
                }
            }
            __syncthreads();
            if (tid < 32) {
                for (int rr = 0; rr < 32; ++rr) { hstate = AB[rr * 32 + tid] * hstate + AB[1024 + rr * 32 + tid]; AB[1024 + rr * 32 + tid] = hstate; }
            }
            __syncthreads();
            {
                const int p = r0 + grow;
                const size_t off = (size_t)(b * TP + p) * DM + ch0 + gc;
                const unsigned gw_ = *(const unsigned*)(G + off);
                const float g0 = bflo(gw_), g1 = bfhi(gw_);
                const float y0 = AB[1024 + grow * 32 + gc] * g0 * sigmoidf_(g0), y1 = AB[1024 + grow * 32 + gc + 1] * g1 * sigmoidf_(g1);
                *(unsigned*)(YG + off) = pk2(y0, y1);
            }
        }
    }
}

namespace scanp {
constexpr int AST = 544, A_BYTES = 64 * AST;
constexpr int L_A = 0, L_UF = 2 * A_BYTES, L_CP = L_UF + 2 * 8192, L_DUMP = L_CP + 2048, L_END = L_DUMP + 4096;
static_assert(L_END <= RING_BYTES, "scan LDS");
}
template <int ABL = 0>
__device__ __forceinline__ void scan_phase_fast(LAS unsigned char* lds, const Args& a, int layer, int wv64_) {
    using namespace scanp;
    const int tid = opaque_tid(), lane = tid & 63, wid = __builtin_amdgcn_readfirstlane(tid >> 6);
    const int fr = lane & 15, fq = lane >> 4, rb = wid >> 1, cb = wid & 1;
    unsigned char* ws = a.ws;
    const bf16_t* U = (const bf16_t*)(ws + WS_U); const bf16_t* G = (const bf16_t*)(ws + WS_G); bf16_t* YG = (bf16_t*)(ws + (ABL ? WS_K : WS_YG));
    for (int unit = blockIdx.x; unit < 256; unit += gridDim.x) {
        const int b = unit & 7, j = unit >> 3, ch0 = 32 * j, blk = j >> 3, kc0 = 256 * blk, oc0 = 32 * (j & 7);
        __syncthreads();
        bf16x8 Br[8], Bi[8];
        {
            const bf16_t* WrT = (const bf16_t*)(ws + WS_WA + (size_t)layer * WA_STRIDE + WA_WR) + (size_t)blk * 65536 + (size_t)(oc0 + 16 * cb + fr) * 256 + 8 * fq;
            const bf16_t* WiT = (const bf16_t*)(ws + WS_WA + (size_t)layer * WA_STRIDE + WA_WI) + (size_t)blk * 65536 + (size_t)(oc0 + 16 * cb + fr) * 256 + 8 * fq;
#pragma unroll
            for (int ks = 0; ks < 8; ++ks) { Br[ks] = *(const bf16x8*)(WrT + 32 * ks); Bi[ks] = *(const bf16x8*)(WiT + 32 * ks); }
        }
        const int chl = layer * DM + ch0 + 16 * cb + fr;
        constexpr float LOG2E = 1.4426950408889634f;
        const float nbr = -LOG2E * a.in[I_ABR][chl], nbi = -LOG2E * a.in[I_ABI][chl];
        float L8v; { const float lam = a.in[I_ALAM][chl]; L8v = -8.0f * ((lam < 0.f ? -lam : 0.f) + log1pf(__expf(-fabsf(lam)))); }
        const float L8l = L8v * LOG2E, L8d = 2.0f * L8v;
        const int cc = tid & 31, rg = tid >> 5;
        f32x2 cw2[4][4], cb2[4];
#pragma unroll
        for (int q = 0; q < 4; ++q) { cb2[q] = *(const f32x2*)(a.in[I_ACONVB] + layer * DM + kc0 + 8 * cc + 2 * q);
#pragma unroll
            for (int k = 0; k < 4; ++k) cw2[k][q] = *(const f32x2*)(a.in[I_ACONVW] + (size_t)layer * 4 * DM + k * DM + kc0 + 8 * cc + 2 * q); }
        const bf16_t* ubase = U + (size_t)(b * TP) * DM + kc0 + 8 * cc;
        u32x4 raw[7];
#define SC_LOAD_RAW(tile) do { _Pragma("unroll") for (int i_ = 0; i_ < 7; ++i_) { int p_ = 64 * (tile) + 4 * rg - 3 + i_; p_ = p_ < 0 ? 0 : p_;     \
            if (ABL & 8) { const unsigned z_ = 0x3f803f80u + (unsigned)(p_ + tid); raw[i_] = (u32x4){z_, z_ + 1u, z_ + 2u, z_ + 3u}; } else raw[i_] = *(const u32x4*)(ubase + (size_t)p_ * DM); } } while (0)
#define SC_STAGE(buf) do { f32x2 c_[4][4]; \
            _Pragma("unroll") for (int rr_ = 0; rr_ < 4; ++rr_) _Pragma("unroll") for (int q_ = 0; q_ < 4; ++q_) c_[rr_][q_] = cb2[q_]; \
            _Pragma("unroll") for (int i_ = 0; i_ < 7; ++i_) { f32x2 u_[4]; u_[0] = (f32x2){bflo(raw[i_].x), bfhi(raw[i_].x)}; u_[1] = (f32x2){bflo(raw[i_].y), bfhi(raw[i_].y)}; \
                u_[2] = (f32x2){bflo(raw[i_].z), bfhi(raw[i_].z)}; u_[3] = (f32x2){bflo(raw[i_].w), bfhi(raw[i_].w)}; \
                _Pragma("unroll") for (int k_ = 0; k_ < 4; ++k_) { if (i_ - k_ >= 0 && i_ - k_ < 4 && (!(ABL & 1) || k_ == 3)) { \
                    _Pragma("unroll") for (int q_ = 0; q_ < 4; ++q_) c_[(i_ - k_) & 3][q_] = cw2[k_][q_] * u_[q_] + c_[(i_ - k_) & 3][q_]; } } } \
            _Pragma("unroll") for (int rr_ = 0; rr_ < 4; ++rr_) { \
                u32x4 o_; o_.x = pg8::cvt_pk_bf16(c_[rr_][0].x, c_[rr_][0].y); o_.y = pg8::cvt_pk_bf16(c_[rr_][1].x, c_[rr_][1].y); o_.z = pg8::cvt_pk_bf16(c_[rr_][2].x, c_[rr_][2].y); o_.w = pg8::cvt_pk_bf16(c_[rr_][3].x, c_[rr_][3].y); \
                *(LAS u32x4*)(lds + L_A + (buf) * A_BYTES + (4 * rg + rr_) * AST + 16 * cc) = o_; \
                } } while (0)
        float h = 0.f;
        SC_LOAD_RAW(0); SC_STAGE(0); SC_LOAD_RAW(1);
        __syncthreads();
        for (int t = 0; t < TP / 64; ++t) {
            const int buf = t & 1;
            unsigned pf = 0u;
            if (wid < 4) { int pr_ = 64 * (t + 4) + (tid >> 2); pr_ = pr_ > TP - 1 ? TP - 1 : pr_; pf = *(const unsigned*)(U + (size_t)(b * TP + pr_) * DM + kc0 + 64 * (tid & 3)); }
            if (t + 1 < TP / 64) SC_STAGE(buf ^ 1);
            const int prow0 = 64 * t + 16 * rb + 4 * fq;
            const size_t goff = (size_t)(b * TP + prow0) * DM + ch0 + 16 * cb + fr;
            bf16_t gv[4];
#pragma unroll
            for (int k = 0; k < 4; ++k) { if (ABL & (8 | 64)) { gv[k] = (bf16_t)0x3f80; } else gv[k] = G[goff + (size_t)k * DM]; }
            asm volatile("" ::: "memory");
            { const int tl_ = t + 2 < TP / 64 ? t + 2 : TP / 64 - 1;
              const bf16_t* up_ = ubase + (size_t)(64 * tl_ + 4 * rg - 3) * DM;
#pragma unroll
              for (int i_ = 0; i_ < 7; ++i_) { if (ABL & 8) { const unsigned z_ = 0x3f803f80u + (unsigned)(i_ + tid); raw[i_] = (u32x4){z_, z_ + 1u, z_ + 2u, z_ + 3u}; } else raw[i_] = *(const u32x4*)(up_ + (size_t)i_ * DM); } }
            f32x4 ar = (f32x4){0.f, 0.f, 0.f, 0.f}, ai = ar;
            {
                const LAS unsigned char* ap = lds + L_A + buf * A_BYTES + (16 * rb + fr) * AST + 16 * fq;
                if (ABL & 2) { const bf16x8 af = *(const LAS bf16x8*)ap; ar = (f32x4){(float)af[0], (float)af[1], (float)af[2], (float)af[3]}; ai = (f32x4){(float)Br[0][0], (float)Bi[0][1], (float)Br[7][2], (float)Bi[7][3]}; }
                else
                {
                    f32x4 ar1 = (f32x4){0.f, 0.f, 0.f, 0.f}, ai1 = ar1;
#pragma unroll
                    for (int ks = 0; ks < 8; ks += 2) { const bf16x8 af0 = *(const LAS bf16x8*)(ap + 64 * ks), af1 = *(const LAS bf16x8*)(ap + 64 * ks + 64);
                        ar = __builtin_amdgcn_mfma_f32_16x16x32_bf16(af0, Br[ks], ar, 0, 0, 0);
                        ai = __builtin_amdgcn_mfma_f32_16x16x32_bf16(af0, Bi[ks], ai, 0, 0, 0);
                        ar1 = __builtin_amdgcn_mfma_f32_16x16x32_bf16(af1, Br[ks + 1], ar1, 0, 0, 0);
                        ai1 = __builtin_amdgcn_mfma_f32_16x16x32_bf16(af1, Bi[ks + 1], ai1, 0, 0, 0); }
                    ar += ar1; ai += ai1;
                }
            }
            float av[4], bv[4];
            {
                const LAS bf16_t* uf = (const LAS bf16_t*)(lds + L_A + buf * A_BYTES + (16 * rb + 4 * fq) * AST) + oc0 + 16 * cb + fr;
#pragma unroll
                for (int k = 0; k < 4; ++k) {
                    if (ABL & 4) { av[k] = 0.5f + 1e-3f * ar[k] + nbr * 1e-9f + L8l * 1e-9f + L8d * 1e-9f; bv[k] = ai[k] * bf2f(uf[k * (AST / 2)]) + nbi * 1e-9f; continue; }
                    const float r = __builtin_amdgcn_rcpf(1.0f + __builtin_amdgcn_exp2f(fmaf(ar[k], -LOG2E, nbr)));
                    const float ig = __builtin_amdgcn_rcpf(1.0f + __builtin_amdgcn_exp2f(fmaf(ai[k], -LOG2E, nbi)));
                    const float avk = __builtin_amdgcn_exp2f(r * L8l);
                    const float em = fmaf(-avk, avk, 1.0f);
                    float bvk = __builtin_amdgcn_sqrtf(em) * ig * bf2f(uf[k * (AST / 2)]);
                    bvk = (prow0 + k < MPOS) ? 0.f : bvk;
                    av[k] = avk; bv[k] = bvk;
                }
            }
            const float P0 = av[0], hl0 = bv[0];
            const float P1 = P0 * av[1], hl1 = av[1] * hl0 + bv[1];
            const float P2 = P1 * av[2], hl2 = av[2] * hl1 + bv[2];
            const float P3 = P2 * av[3], hl3 = av[3] * hl2 + bv[3];
            float A = P3, Bc = hl3;
            { const float At = __shfl_up(A, 16), Bt = __shfl_up(Bc, 16); if (fq >= 1) { Bc = A * Bt + Bc; A = A * At; } }
            { const float At = __shfl_up(A, 32), Bt = __shfl_up(Bc, 32); if (fq >= 2) { Bc = A * Bt + Bc; A = A * At; } }
            float Ae = __shfl_up(A, 16), Be = __shfl_up(Bc, 16); if (fq == 0) { Ae = 1.f; Be = 0.f; }
            LAS f32x2* cp = (LAS f32x2*)(lds + L_CP + buf * 1024);
            { LAS f32x2* cw_ = fq == 3 ? cp + (rb * 2 + cb) * 16 + fr : (LAS f32x2*)(lds + L_DUMP + 2048) + lane; *cw_ = (f32x2){A, Bc}; }
            if (!(ABL & 16)) __syncthreads();
            float hin = h, hout = h;
#pragma unroll
            for (int r2 = 0; r2 < 4; ++r2) { const f32x2 c2 = cp[(r2 * 2 + cb) * 16 + fr]; if (r2 < rb) hin = c2.x * hin + c2.y; hout = c2.x * hout + c2.y; }
            const float hs = Ae * hin + Be;
            const float hk[4] = {P0 * hs + hl0, P1 * hs + hl1, P2 * hs + hl2, P3 * hs + hl3};
#pragma unroll
            for (int k = 0; k < 4; ++k) { const float g = bf2f(gv[k]); const float y = hk[k] * g * __builtin_amdgcn_rcpf(1.0f + __builtin_amdgcn_exp2f(-LOG2E * g));
                if (ABL & (8 | 32)) { asm volatile("" :: "v"(y)); } else YG[goff + (size_t)k * DM] = (bf16_t)pg8::cvt_pk_bf16(y, 0.f); }
            h = hout;
            asm volatile("" :: "v"(pf));
        }
#undef SC_LOAD_RAW
#undef SC_STAGE
    }
}

__device__ __forceinline__ void f_job(const bf16_t* Arows, const bf16_t* WfT, const float* ssrow, const float* b_f, float* LS, int b_lo, int b_hi, int pos0, int lane) {
    const int fr = lane & 15, fq = lane >> 4;
    f32x4 acc = (f32x4){0.f, 0.f, 0.f, 0.f};
#pragma unroll
    for (int h = 0; h < 2; ++h) {
        bf16x8 av[16], bv[16];
#pragma unroll
        for (int i = 0; i < 16; ++i) { const int k = 32 * (16 * h + i) + 8 * fq;
            av[i] = *(const bf16x8*)(Arows + (size_t)fr * DM + k); bv[i] = *(const bf16x8*)(WfT + (size_t)fr * DM + k); }
#pragma unroll
        for (int i = 0; i < 16; ++i) asm volatile("" : "+v"(av[i]), "+v"(bv[i]) :: "memory");
#pragma unroll
        for (int i = 0; i < 16; ++i) acc = __builtin_amdgcn_mfma_f32_16x16x32_bf16(av[i], bv[i], acc, 0, 0, 0);
    }
    if (fr < NH) {
        float ssv[4];
#pragma unroll
        for (int r = 0; r < 4; ++r) ssv[r] = ssrow[4 * fq + r];
        const float bfv = b_f[fr];
        asm volatile("" ::: "memory");
#pragma unroll
        for (int r = 0; r < 4; ++r) { const int row = 4 * fq + r;
            const float rs = 1.0f / sqrtf(ssv[r] * (1.0f / DM) + EPS);
            const float z = acc[r] * rs + bfv;
            const float ls = fminf(z, 0.f) - log1pf(__expf(-fabsf(z)));
            for (int b = b_lo; b < b_hi; ++b) LS[(size_t)(b * NH + fr) * TP + pos0 + row] = ls; }
    }
}
__device__ __forceinline__ void f_phase(const Args& a, int wv64_) {
    const int tid = opaque_tid(), lane = tid & 63, wave = __builtin_amdgcn_readfirstlane(tid >> 6);
    unsigned char* ws = a.ws;
    const bf16_t* XB = (const bf16_t*)(ws + WS_XB); const bf16_t* WfT = (const bf16_t*)(ws + WS_WF);
    const float* ss = (const float*)(ws + WS_CTL + CTL_SS) + 2 * MROWS; const float* ssm = (const float*)(ws + WS_CTL + CTL_SSM) + 2 * 16;
    float* LS = (float*)(ws + WS_LS);
    if ((wave & 1) == 0) {
        if (gridDim.x == 256) {
            const int c = blockIdx.x, pm = 8 * (c & 7) + ((c >> 3) & 7);
            const int m0 = pm * 256 + (c >> 6) * 64 + 16 * (wave >> 1), b = m0 >> 11, t0 = m0 & 2047;
            f_job(XB + (size_t)prow(m0) * DM, WfT, ss + m0, a.in[I_BF], LS, b, b + 1, RPOS + t0, lane);
        } else
        for (int job = blockIdx.x * 4 + (wave >> 1); job < MROWS / 16; job += gridDim.x * 4) {
            const int m0 = job * 16, b = m0 >> 11, t0 = m0 & 2047;
            f_job(XB + (size_t)prow(m0) * DM, WfT, ss + m0, a.in[I_BF], LS, b, b + 1, RPOS + t0, lane);
        }
    } else if (blockIdx.x == 0 && wave == 1) {
        f_job(XB + (size_t)MPOS * DM, WfT, ssm, a.in[I_BF], LS, 0, NB, MPOS, lane);
    }
}

__device__ __forceinline__ void attn_phase_naive(const Args& a, int wv64_) {
    const int tid = opaque_tid(), lane = tid & 63, wave = __builtin_amdgcn_readfirstlane(tid >> 6);
    unsigned char* ws = a.ws;
    const bf16_t* Q = (const bf16_t*)(ws + WS_U); const bf16_t* K = (const bf16_t*)(ws + WS_K); const bf16_t* V = (const bf16_t*)(ws + WS_V);
    const bf16_t* G = (const bf16_t*)(ws + WS_G); bf16_t* YG = (bf16_t*)(ws + WS_YG); const float* LS = (const float*)(ws + WS_LS);
    const int gw = blockIdx.x * NWAVES + wave, NGW = gridDim.x * NWAVES;
    const int total = NB * NH * (TP - MPOS);
    for (int idx = gw; idx < total; idx += NGW) {
        const int pi = idx >> 6, bh = idx & 63, p = MPOS + pi, b = bh >> 3, h = bh & 7;
        const size_t qoff = (size_t)(b * TP + p) * DM + h * HD + 2 * lane;
        const unsigned qw = *(const unsigned*)(Q + qoff);
        const float q0 = bflo(qw), q1 = bfhi(qw);
        const float* ls = LS + (size_t)(b * NH + h) * TP;
        float cs = 0.f; for (int s = MPOS + lane; s <= p; s += 64) cs += ls[s];
        const float Cp = wave_sum(cs);
        float m = -1e30f, l = 0.f, o0 = 0.f, o1 = 0.f, c = 0.f;
        const bf16_t* kp = K + (size_t)(b * TP) * DM + h * HD + 2 * lane; const bf16_t* vp = V + (size_t)(b * TP) * DM + h * HD + 2 * lane;
        for (int s = MPOS; s <= p; ++s) {
            c += ls[s];
            const unsigned kw = *(const unsigned*)(kp + (size_t)s * DM);
            const unsigned vw = *(const unsigned*)(vp + (size_t)s * DM);
            const float dot = wave_sum(q0 * bflo(kw) + q1 * bfhi(kw));
            const float logit = dot * SCALE + (Cp - c);
            const float mn = fmaxf(m, logit), al = __expf(m - mn), pe = __expf(logit - mn);
            l = l * al + pe; o0 = o0 * al + pe * bflo(vw); o1 = o1 * al + pe * bfhi(vw); m = mn;
        }
        const float il = 1.0f / l;
        const unsigned gw_ = *(const unsigned*)(G + qoff);
        const float g0 = bflo(gw_), g1 = bfhi(gw_);
        *(unsigned*)(YG + qoff) = pk2(o0 * il * g0, o1 * il * g1);
    }
}

namespace att {
using bf16 = __hip_bfloat16;
typedef short s16x4 __attribute__((ext_vector_type(4)));
typedef float f32x16 __attribute__((ext_vector_type(16)));
constexpr int NW = 8, QBLK = 32, KVBLK = 64, QB = NW * QBLK, D = 128, RS = DM;
constexpr int SHM_V = KVBLK * D * 2, SHM_K = KVBLK * D * 2;
constexpr int NRING = 3;
constexpr int LDS_WS = NRING * (SHM_V + SHM_K);
constexpr int LDS_BIAS = LDS_WS + NW * 64 * 4;
constexpr int LDS_SCAN = LDS_BIAS + 2 * TP * 4;
constexpr int LDS_TOTAL = LDS_SCAN + 64;
static_assert(LDS_TOTAL <= RING_BYTES, "attention LDS");
constexpr float THR = 8.f;
#define KSWZ(row, colB) ((row) * 256 + ((colB) ^ (((row) & 7) << 4)))
#define SBAR() __builtin_amdgcn_sched_barrier(0)
__device__ __forceinline__ int v_st(int k, int c) { const int kk = (k & ~0xC) | ((k & 4) << 1) | ((k & 8) >> 1); return ((kk >> 3) * 4 + (c >> 5)) * 512 + ((kk & 7) * 32 + (c & 31)) * 2; }
__device__ __forceinline__ int v_rd_base(int lane) { return ((lane & 3) << 3) | (((lane >> 2) & 3) << 6) | (((lane >> 4) & 1) << 5) | (((lane >> 5) & 1) << 8); }
constexpr int v_rd_off(int d0, int ks, int half) { return d0 * 512 + ks * 4096 + half * 2048; }
__device__ __forceinline__ int crow(int r, int hi) { return (r & 3) + 8 * (r >> 2) + 4 * hi; }
__device__ __forceinline__ unsigned cvtpk(float lo, float hi) { unsigned r; asm volatile("v_cvt_pk_bf16_f32 %0, %1, %2" : "=v"(r) : "v"(lo), "v"(hi)); return r; }
__device__ __forceinline__ bf16x8 load8(const bf16* p) { return *reinterpret_cast<const bf16x8*>(p); }
__device__ __forceinline__ void mask_tile(f32x16& p0, f32x16& p1, int dq) {
    const float NEG = -__builtin_inff();
#pragma unroll
    for (int r = 0; r < 16; ++r) {
        const int c = (r & 3) + 8 * (r >> 2);
        if (dq - c < 0) p0[r] = NEG;
        if (dq - c - 32 < 0) p1[r] = NEG;
    }
}
__device__ __forceinline__ void partialSM(f32x16& p0, f32x16& p1, float& m_reg, float& mn, float& alpha) {
    constexpr float C2 = 1.4426950408889634f * SCALE;
    mn = m_reg; alpha = 1.f;
    const float mnL = -mn * C2;
    for (int r = 0; r < 16; ++r) p0[r] = fmaf(p0[r], C2, mnL); for (int r = 0; r < 16; ++r) p1[r] = fmaf(p1[r], C2, mnL);
    for (int r = 0; r < 16; ++r) p0[r] = __builtin_amdgcn_exp2f(p0[r]);
}
__device__ __forceinline__ void finishSM(f32x16& p0, f32x16& p1, float alpha, float& l_reg, bf16x8& pa0, bf16x8& pa1, bf16x8& pa2, bf16x8& pa3) {
    for (int r = 0; r < 16; ++r) p1[r] = __builtin_amdgcn_exp2f(p1[r]);
    float ps = 0; for (int r = 0; r < 16; ++r) ps += p0[r]; for (int r = 0; r < 16; ++r) ps += p1[r];
    { auto rr = __builtin_amdgcn_permlane32_swap(__float_as_uint(ps), __float_as_uint(ps), false, false);
      ps = __uint_as_float(rr[0]) + __uint_as_float(rr[1]); }
    l_reg = l_reg * alpha + ps;
#define PK4(P, B_, OUT) do { unsigned a0 = cvtpk(P[B_+0], P[B_+1]), a1 = cvtpk(P[B_+2], P[B_+3]);                          \
        unsigned b0 = cvtpk(P[B_+4], P[B_+5]), b1 = cvtpk(P[B_+6], P[B_+7]);                                             \
        auto r0 = __builtin_amdgcn_permlane32_swap(a0, b0, false, false); auto r1 = __builtin_amdgcn_permlane32_swap(a1, b1, false, false); \
        u32x4 w = {r0[0], r1[0], r0[1], r1[1]}; OUT = *reinterpret_cast<bf16x8*>(&w); } while (0)
    PK4(p0, 0, pa0); PK4(p0, 8, pa1); PK4(p1, 0, pa2); PK4(p1, 8, pa3);
#undef PK4
}
__device__ __forceinline__ void qkt(int kofs, f32x16& p0, f32x16& p1, const char* K_lds, const LAS float* bt, int r32, int hi, const bf16x8* qr) {
#pragma unroll
    for (int g = 0; g < 4; ++g) { const f32x4 b0 = *(const LAS f32x4*)(bt + 8 * g), b1 = *(const LAS f32x4*)(bt + 32 + 8 * g);
#pragma unroll
        for (int i = 0; i < 4; ++i) { p0[4 * g + i] = b0[i]; p1[4 * g + i] = b1[i]; } }
    const char* kb[4];
#pragma unroll
    for (int dd = 0; dd < 4; ++dd) kb[dd] = K_lds + kofs + KSWZ(r32, (dd * 16 + hi * 8) * 2);
#pragma unroll
    for (int d0 = 0; d0 < 8; ++d0) { const char* a = kb[d0 & 3] + (d0 >> 2) * 128;
        bf16x8 b0 = *reinterpret_cast<const bf16x8*>(a);
        bf16x8 b1 = *reinterpret_cast<const bf16x8*>(a + 32 * 256);
        p0 = __builtin_amdgcn_mfma_f32_32x32x16_bf16(b0, qr[d0], p0, 0, 0, 0);
        p1 = __builtin_amdgcn_mfma_f32_32x32x16_bf16(b1, qr[d0], p1, 0, 0, 0); }
}
__device__ __forceinline__ void pv_tile(f32x16* o, int vb0, bf16x8 pa0, bf16x8 pa1, bf16x8 pa2, bf16x8 pa3) {
#define TRRD(dst, off) asm volatile("ds_read_b64_tr_b16 %0, %1 offset:%2" : "=&v"(dst) : "v"(vb0), "i"(off) : "memory")
#define PV_D0(d0) do { s16x4 l0, l1, l2, l3, h0, h1, h2, h3; constexpr int b_ = v_rd_off(d0, 0, 0); \
        TRRD(l0, b_); TRRD(h0, b_ + 2048); TRRD(l1, b_ + 4096); TRRD(h1, b_ + 6144); TRRD(l2, b_ + 8192); TRRD(h2, b_ + 10240); TRRD(l3, b_ + 12288); TRRD(h3, b_ + 14336); \
        asm volatile("s_waitcnt lgkmcnt(0)" ::: "memory"); SBAR();   \
        o[d0] = __builtin_amdgcn_mfma_f32_32x32x16_bf16(pa0, (bf16x8){l0[0], l0[1], l0[2], l0[3], h0[0], h0[1], h0[2], h0[3]}, o[d0], 0, 0, 0);   \
        o[d0] = __builtin_amdgcn_mfma_f32_32x32x16_bf16(pa1, (bf16x8){l1[0], l1[1], l1[2], l1[3], h1[0], h1[1], h1[2], h1[3]}, o[d0], 0, 0, 0);   \
        o[d0] = __builtin_amdgcn_mfma_f32_32x32x16_bf16(pa2, (bf16x8){l2[0], l2[1], l2[2], l2[3], h2[0], h2[1], h2[2], h2[3]}, o[d0], 0, 0, 0);   \
        o[d0] = __builtin_amdgcn_mfma_f32_32x32x16_bf16(pa3, (bf16x8){l3[0], l3[1], l3[2], l3[3], h3[0], h3[1], h3[2], h3[3]}, o[d0], 0, 0, 0); } while (0)
    PV_D0(0); PV_D0(1); PV_D0(2); PV_D0(3);
#undef PV_D0
#undef TRRD
}
struct BlockRef { unsigned char* ws; int g, t, jlo;
    __device__ __forceinline__ int P0() const { return RPOS + (7 - (t >> 3)) * 256; }
    __device__ __forceinline__ size_t koff() const { return (size_t)(g * TP) * DM + (t & 7) * HD; }
    __device__ __forceinline__ size_t qoff() const { return koff() + (size_t)P0() * DM; }
    __device__ __forceinline__ const bf16* Q() const { return (const bf16*)(ws + WS_U) + qoff(); }
    __device__ __forceinline__ const bf16* K() const { return (const bf16*)(ws + WS_K) + koff(); }
    __device__ __forceinline__ const bf16* V() const { return (const bf16*)(ws + WS_V) + koff(); }
    __device__ __forceinline__ const bf16_t* Gt() const { return (const bf16_t*)(ws + WS_G) + qoff(); }
    __device__ __forceinline__ bf16* O() const { return (bf16*)(ws + WS_YG) + qoff(); } };
struct Seam { bf16x8 qr[8]; bf16x8 st_v0, st_v1, st_k0, st_k1; };
#define ROW(p, k0, rr) ((p) + (size_t)((k0) + (rr)) * RS + sc)
#define VMW() asm volatile("s_waitcnt vmcnt(0)" ::: "memory")
#define VMWN(n) asm volatile("s_waitcnt vmcnt(%0)" :: "i"(n) : "memory")
#define SLOAD_H(Kp, Vp, k0) do { S.st_v0 = load8(ROW(Vp, k0, sr)); S.st_v1 = load8(ROW(Vp, k0, 32 + sr));              \
                         S.st_k0 = load8(ROW(Kp, k0, sr)); S.st_k1 = load8(ROW(Kp, k0, 32 + sr)); } while (0)
#define SWRITE_HK(bf) do { *(bf16x8*)(K_lds + (bf) + kws) = S.st_k0; *(bf16x8*)(K_lds + (bf) + kws + 32 * 256) = S.st_k1; } while (0)
#define SWRITE_HV(bf) do { *(bf16x8*)(V_lds + (bf) + vst0) = S.st_v0; *(bf16x8*)(V_lds + (bf) + vst1) = S.st_v1; } while (0)
#define SWRITE_H(bf) do { SWRITE_HV(bf); SWRITE_HK(bf); } while (0)
__device__ __forceinline__ void prime(const BlockRef& cur, char* lds, Seam& S, int wv64_) {
    const int tid = opaque_tid(), wid = __builtin_amdgcn_readfirstlane(tid >> 6), lane = tid & 63, r32 = lane & 31, hi = lane >> 5;
    const int sr = tid >> 4, sc = (tid & 15) * 8, kws = KSWZ(sr, sc * 2); char* K_lds = lds + NRING * SHM_V;
    for (int d0 = 0; d0 < 8; ++d0) S.qr[d0] = load8(cur.Q() + (size_t)(wid * QBLK + r32) * RS + d0 * 16 + hi * 8);
    SLOAD_H(cur.K(), cur.V(), cur.jlo * KVBLK); VMW(); SWRITE_HK(0);
    __syncthreads();
}
__device__ __forceinline__ int make_bias(char* lds, const float* ls, int sel, int P0, int wv64_);
__device__ __forceinline__ int next_ticket(char* lds, unsigned* counter, int wv64_);
__device__ __forceinline__ void block(const BlockRef& cur, BlockRef& nxt, bool& more, unsigned* counter, const float* LSg, const unsigned char* order, int sel,
                                      int skv, char* lds, const LAS float* biasL, float Bqk, Seam& S, int wv64_) {
    const int tid = opaque_tid(), wid = __builtin_amdgcn_readfirstlane(tid >> 6), lane = tid & 63, r32 = lane & 31, hi = lane >> 5;
    const int P0c = cur.P0();
    int j_hi = (P0c + QB - 1) / KVBLK + 1; if (j_hi > skv / KVBLK) j_hi = skv / KVBLK;
    const int jl = cur.jlo, NT = j_hi - jl;
    const int qlo = P0c + wid * QBLK, qm = qlo + r32 - 4 * hi;
    char* V_lds = lds; char* K_lds = lds + NRING * SHM_V;
    float* ws = (float*)(lds + LDS_WS) + wid * 64; float* li_l = ws, * al_l = ws + 32;
    float m_reg = Bqk + biasL[qlo + r32], l_reg = 0; f32x16 o[4] = {};
    const int sr = tid >> 4, sc = (tid & 15) * 8, vst0 = v_st(sr, sc), vst1 = v_st(32 + sr, sc), kws = KSWZ(sr, sc * 2);
    const int vb0 = (int)(uintptr_t)V_lds + v_rd_base(lane);
    const bf16* Kh = cur.K(); const bf16* Vh = cur.V();
    const LAS float* bh_ = biasL + 4 * hi;
#define RESC(a) do { if (__any((a) < 1.f)) { if (hi == 0) al_l[r32] = (a); asm volatile("s_waitcnt lgkmcnt(0)" ::: "memory");              \
                     for (int d_ = 0; d_ < 4; ++d_) for (int r = 0; r < 16; ++r) o[d_][r] *= al_l[crow(r, hi)]; } } while (0)
#define KBASE(t) ((jl + (t)) * KVBLK)
#define MASKT(P0_, P1_, t) do { const int kb_ = KBASE(t); if (kb_ + KVBLK - 1 > qlo) mask_tile(P0_, P1_, qm - kb_); } while (0)
    constexpr int NQL = 8;
#define SEAM_K0() do { VMWN(NQL); SWRITE_HK(0); SBAR(); } while (0)
    f32x16 pA0, pA1, pB0, pB1; float mnA, mnB, alA, alB; bf16x8 pa0, pa1, pa2, pa3;
    int rc = 0, rp = 0, rn = SHM_K;
#define ROT() do { rp = rc; rc = rn; rn = (rn == (NRING - 1) * SHM_K) ? 0 : rn + SHM_K; } while (0)
    SWRITE_HV(0); SBAR();
    if (NT > 1) { SLOAD_H(Kh, Vh, KBASE(1)); }
    SBAR(); qkt(0, pA0, pA1, K_lds, bh_ + KBASE(0), r32, hi, S.qr);
    MASKT(pA0, pA1, 0); partialSM(pA0, pA1, m_reg, mnA, alA);
    if (NT > 1) { VMW(); SWRITE_H(rn); }
    __syncthreads();
#define HALF_STEP(PX0, PX1, mnX, alX, PY0, PY1, alY, t) do { ROT();                                                           \
        SBAR(); qkt(rc, PX0, PX1, K_lds, bh_ + KBASE(t), r32, hi, S.qr);                                                      \
        finishSM(PY0, PY1, alY, l_reg, pa0, pa1, pa2, pa3); SBAR();                                                           \
        if ((t) + 1 < NT) { SLOAD_H(Kh, Vh, KBASE((t) + 1)); SBAR(); }                                                        \
        pv_tile(o, vb0 + rp, pa0, pa1, pa2, pa3); MASKT(PX0, PX1, (t)); partialSM(PX0, PX1, m_reg, mnX, alX);                 \
        if ((t) + 1 < NT) { VMW(); SWRITE_H(rn); }                                                                            \
        __syncthreads(); } while (0)
    for (int t = 1; t + 1 < NT; t += 2) {
        HALF_STEP(pB0, pB1, mnB, alB, pA0, pA1, alA, t);
        HALF_STEP(pA0, pA1, mnA, alA, pB0, pB1, alB, t + 1);
    }
    const bool even = (NT & 1) == 0;
    if (even) { ROT(); SBAR(); qkt(rc, pB0, pB1, K_lds, bh_ + KBASE(NT - 1), r32, hi, S.qr); SBAR(); }
    {
        int t1 = next_ticket(lds, counter, wv64_);
        more = t1 < 64;
        if (more) { t1 = (int)order[t1 & 63]; const int jl_ = make_bias(lds, LSg + (size_t)(t1 & 7) * TP, sel ^ 1, RPOS + (7 - (t1 >> 3)) * 256, wv64_); nxt.ws = cur.ws; nxt.g = cur.g; nxt.t = t1; nxt.jlo = jl_; }
        else nxt = cur;
    }
    SLOAD_H(nxt.K(), nxt.V(), nxt.jlo * KVBLK); SBAR();
    { const bf16* nq_ = nxt.Q() + (size_t)(wid * QBLK + r32) * RS + hi * 8;
#pragma unroll
    for (int d0 = 0; d0 < 8; ++d0) S.qr[d0] = load8(nq_ + d0 * 16); }
    SBAR();
    finishSM(pA0, pA1, alA, l_reg, pa0, pa1, pa2, pa3); SBAR();
    pv_tile(o, vb0 + (even ? rp : rc), pa0, pa1, pa2, pa3);
    if (even) { MASKT(pB0, pB1, NT - 1); partialSM(pB0, pB1, m_reg, mnB, alB); __syncthreads();
        finishSM(pB0, pB1, alB, l_reg, pa0, pa1, pa2, pa3); SBAR(); pv_tile(o, vb0 + rc, pa0, pa1, pa2, pa3); }
    __syncthreads();
#undef ROT
    SBAR(); SEAM_K0();
    if (hi == 0) li_l[r32] = l_reg; asm volatile("s_waitcnt lgkmcnt(0)" ::: "memory");
    float rli[16];
#pragma unroll
    for (int r = 0; r < 16; ++r) rli[r] = __builtin_amdgcn_rcpf(li_l[crow(r, hi)]);
    bf16* Ow = cur.O() + (size_t)(wid * QBLK) * RS; const bf16_t* Gw = cur.Gt() + (size_t)(wid * QBLK) * RS;
    u32x4 gvv[8];
#pragma unroll
    for (int i = 0; i < 8; ++i) gvv[i] = *(const u32x4*)(Gw + (size_t)(4 * i + (lane >> 4)) * RS + (lane & 15) * 8);
    asm volatile("" ::: "memory");
    { LAS unsigned char* stg = (LAS unsigned char*)(wid < 4 ? V_lds + SHM_V + wid * 8192 : K_lds + SHM_K + (wid - 4) * 8192);
#pragma unroll
      for (int r = 0; r < 16; ++r) { const int orow = crow(r, hi);
#pragma unroll
        for (int d0 = 0; d0 < 4; ++d0) { const float v = o[d0][r] * rli[r]; const float vn = __shfl_xor(v, 1);
            if ((r32 & 1) == 0) *(LAS unsigned*)(stg + orow * 256 + (d0 * 32 + r32) * 2) = cvtpk(v, vn); } }
      asm volatile("s_waitcnt lgkmcnt(0)" ::: "memory");
#pragma unroll
      for (int i = 0; i < 8; ++i) { const int row = 4 * i + (lane >> 4), ch = lane & 15;
          const u32x4 ov = *(const LAS u32x4*)(stg + row * 256 + ch * 16);
          const u32x4 gv = gvv[i];
          u32x4 w; w.x = cvtpk(bflo(ov.x) * bflo(gv.x), bfhi(ov.x) * bfhi(gv.x)); w.y = cvtpk(bflo(ov.y) * bflo(gv.y), bfhi(ov.y) * bfhi(gv.y));
          w.z = cvtpk(bflo(ov.z) * bflo(gv.z), bfhi(ov.z) * bfhi(gv.z)); w.w = cvtpk(bflo(ov.w) * bflo(gv.w), bfhi(ov.w) * bfhi(gv.w));
          *(u32x4*)(Ow + (size_t)row * RS + ch * 8) = w; } }
    __syncthreads();
#undef RESC
#undef KBASE
#undef MASKT
#undef SEAM_K0
#undef HALF_STEP
}
#undef ROW
#undef VMW
#undef VMWN
#undef SLOAD_H
#undef SWRITE_HK
#undef SWRITE_HV
#undef SWRITE_H
#undef KSWZ
#undef SBAR
__device__ __forceinline__ int make_bias(char* lds, const float* ls, int sel, int P0, int wv64_) {
    const int tid = opaque_tid(), lane = tid & 63, wid = tid >> 6;
    LAS float* biasL = (LAS float*)((LAS unsigned char*)lds + LDS_BIAS) + sel * TP; LAS float* tot = (LAS float*)((LAS unsigned char*)lds + LDS_SCAN);
    float v[8]; float run = 0.f;
    if (tid < TP / 8) { const f32x4 a0 = *(const f32x4*)(ls + 8 * tid), a1 = *(const f32x4*)(ls + 8 * tid + 4);
        v[0] = a0[0]; v[1] = a0[1]; v[2] = a0[2]; v[3] = a0[3]; v[4] = a1[0]; v[5] = a1[1]; v[6] = a1[2]; v[7] = a1[3]; }
    else {
#pragma unroll
        for (int e = 0; e < 8; ++e) v[e] = 0.f; }
#pragma unroll
    for (int e = 0; e < 8; ++e) { run += v[e]; v[e] = run; }
    float inc = run;
#pragma unroll
    for (int o = 1; o < 64; o <<= 1) { const float t = __uint_as_float(__builtin_amdgcn_ds_bpermute(4 * (lane - o), __float_as_uint(inc))); if (lane >= o) inc += t; }
    if (lane == 63) tot[wid] = inc;
    __syncthreads();
    float base = inc - run;
    for (int w = 0; w < wid; ++w) base += tot[w];
    if (tid < TP / 8) {
#pragma unroll
        for (int e = 0; e < 8; ++e) { const int pos = 8 * tid + e; biasL[pos] = pos < MPOS ? -__builtin_inff() : -(base + v[e]) * (1.0f / SCALE); } }
    __syncthreads();
    if (tid < 64) {
        const int kt = tid < TP / KVBLK ? tid : TP / KVBLK - 1;
        const bool live = (biasL[KVBLK * kt + KVBLK - 1] - biasL[P0]) * (1.4426950408889634f * SCALE) >= -160.0f;
        const unsigned long long m = __ballot(live && tid < TP / KVBLK);
        if (tid == 0) ((LAS int*)tot)[15] = m ? (int)__builtin_ctzll(m) : 0;
    }
    __syncthreads();
    const int jlo = __builtin_amdgcn_readfirstlane(((LAS int*)tot)[15]);
    return jlo;
}
__device__ __forceinline__ int next_ticket(char* lds, unsigned* counter, int wv64_) {
    LAS int* slot = (LAS int*)((LAS unsigned char*)lds + LDS_SCAN) + 14;
    if (opaque_tid() == 0) *slot = (int)__hip_atomic_fetch_add(counter, 1u, __ATOMIC_RELAXED, __HIP_MEMORY_SCOPE_AGENT);
    __syncthreads();
    const int t = __builtin_amdgcn_readfirstlane(*slot);
    __syncthreads();
    return t;
}
}

__device__ __forceinline__ void attn_phase_fast(char* lds, const Args& a, const float* qnorm, int qsel, int wv64_) {
    unsigned char* ws = a.ws;
    const float* LS = (const float*)(ws + WS_LS);
    const int G_ = gridDim.x, bx = blockIdx.x;
    const int vcu = (G_ % 8 == 0) ? (bx % 8) * (G_ / 8) + bx / 8 : bx;
    const LAS float* biasL = (const LAS float*)((LAS unsigned char*)lds + att::LDS_BIAS);
    float Bqk;
    { const int lane = opaque_tid() & 63; float mq = fmaxf(fabsf(qnorm[lane]), fabsf(qnorm[lane + 64])), mk = fmaxf(fabsf(a.in[I_KNORM][lane]), fabsf(a.in[I_KNORM][lane + 64]));
#pragma unroll
      for (int o = 1; o < 64; o <<= 1) { mq = fmaxf(mq, __shfl_xor(mq, o)); mk = fmaxf(mk, __shfl_xor(mk, o)); }
      Bqk = (float)HD * mq * mk * 1.0001f; }
    const int g = bx & 7;
    unsigned* counter = (unsigned*)(ws + WS_CTL) + CW_Q + (qsel * 8 + g) * 64;
    (void)vcu;
#define ATT_REF(R, t_, jlo_) do { R.ws = ws; R.g = g; R.t = (t_); R.jlo = (jlo_); } while (0)
    static constexpr unsigned char UNIT_ORDER[64] = {5, 6, 7, 4, 12, 13, 14, 15, 20, 21, 22, 23, 28, 29, 30, 31, 3, 11, 19, 27, 35, 36, 37, 38, 39, 2, 10, 18, 26, 34, 42, 43, 44, 45, 46, 47, 1, 9, 17, 25, 33, 41, 0, 8, 16, 24, 32, 40, 48, 49, 50, 51, 52, 53, 54, 55, 56, 57, 58, 59, 60, 61, 62, 63};
#define ATT_UNIT(tk) ((int)UNIT_ORDER[(tk) & 63])
    static constexpr unsigned char UNIT_BIN[96] = {9, 0, 50, 45, 49, 54, 42, 48, 51, 44, 47, 60, 46, 43, 62, 36, 53, 58, 37, 34, 255, 39, 18, 255, 35, 26, 255, 19, 1, 255, 3, 25, 255, 38, 2, 255, 27, 41, 255, 11, 33, 255,
        17, 55, 52, 10, 32, 61, 6, 255, 255, 7, 255, 255, 5, 255, 255, 31, 8, 255, 30, 24, 255, 29, 16, 255, 28, 40, 255, 22, 56, 255, 20, 57, 255, 21, 63, 255, 23, 59, 255, 14, 255, 255, 4, 255, 255, 13, 255, 255, 12, 255, 255, 15, 255, 255};
    int t0 = att::next_ticket(lds, counter, wv64_);
    if (t0 < 64) {
        int sel = 0;
        att::BlockRef cur, nxt;
        t0 = ATT_UNIT(t0);
        { const int jl = att::make_bias(lds, LS + (size_t)(g * NH + (t0 & 7)) * TP, sel, RPOS + (7 - (t0 >> 3)) * 256, wv64_); ATT_REF(cur, t0, jl); }
        att::Seam S;
        att::prime(cur, lds, S, wv64_);
        for (;;) {
            bool more = false;
            att::block(cur, nxt, more, counter, LS + (size_t)(g * NH) * TP, UNIT_ORDER, sel, TP, lds, biasL + sel * TP, Bqk, S, wv64_);
            if (!more) break;
            cur = nxt; sel ^= 1;
        }
    }
#undef ATT_REF
#undef ATT_UNIT
}
__device__ __forceinline__ void attn_meta_rows(const Args& a, int wv64_) {
    const int tid = opaque_tid(), lane = tid & 63, wave = __builtin_amdgcn_readfirstlane(tid >> 6);
    if (opaque_bid() >= NMETA) return;
    unsigned char* ws = a.ws;
    const bf16_t* Q = (const bf16_t*)(ws + WS_U); const bf16_t* K = (const bf16_t*)(ws + WS_K); const bf16_t* V = (const bf16_t*)(ws + WS_V);
    const bf16_t* G = (const bf16_t*)(ws + WS_G); bf16_t* YG = (bf16_t*)(ws + WS_YG); const float* LS = (const float*)(ws + WS_LS);
    const int p = MPOS + opaque_bid(), h = wave, np = p - MPOS + 1;
    const size_t qoff = (size_t)p * DM + h * HD + 2 * lane;
    const unsigned qw = *(const unsigned*)(Q + qoff);
    const unsigned gw_ = *(const unsigned*)(G + qoff);
    const float q0 = bflo(qw), q1 = bfhi(qw);
    const float* ls = LS + (size_t)h * TP + MPOS;
    unsigned kw[NMETA], vw[NMETA]; float lsv[NMETA], dot[NMETA];
#pragma unroll
    for (int s = 0; s < NMETA; ++s) { const int sc = s < np ? s : np - 1; const size_t ko = (size_t)(MPOS + sc) * DM + h * HD + 2 * lane;
        kw[s] = *(const unsigned*)(K + ko); vw[s] = *(const unsigned*)(V + ko); lsv[s] = ls[sc]; }
#pragma unroll
    for (int s = 0; s < NMETA; ++s) dot[s] = q0 * bflo(kw[s]) + q1 * bfhi(kw[s]);
#pragma unroll
    for (int o = 1; o < 64; o <<= 1) {
#pragma unroll
        for (int s = 0; s < NMETA; ++s) dot[s] += __shfl_xor(dot[s], o);
    }
    float Cp = 0.f;
#pragma unroll
    for (int s = 0; s < NMETA; ++s) Cp += (s < np) ? lsv[s] : 0.f;
    float logit[NMETA], c = 0.f, m = -1e30f;
#pragma unroll
    for (int s = 0; s < NMETA; ++s) { c += lsv[s]; logit[s] = (s < np) ? dot[s] * SCALE + (Cp - c) : -1e30f; m = fmaxf(m, logit[s]); }
    float l = 0.f, o0 = 0.f, o1 = 0.f;
#pragma unroll
    for (int s = 0; s < NMETA; ++s) { const float pe = (s < np) ? __expf(logit[s] - m) : 0.f; l += pe; o0 += pe * bflo(vw[s]); o1 += pe * bfhi(vw[s]); }
    const float il = 1.0f / l;
    *(unsigned*)(YG + qoff) = pk2(o0 * il * bflo(gw_), o1 * il * bfhi(gw_));
}

__global__ void __launch_bounds__(NTHREADS, 2) yoco_fwd(Args a) {
    extern __shared__ __attribute__((aligned(16))) unsigned char lds_raw[];
    LAS unsigned char* lds = (LAS unsigned char*)lds_raw;
    volatile LAS unsigned* MISC = (volatile LAS unsigned*)(lds + MISC_OFF);
    const int wv64_ = __builtin_amdgcn_readfirstlane(threadIdx.x >> 6) << 6;
    const int tid = opaque_tid();
    unsigned char* ws = a.ws;
    gu32* ctl = (gu32*)(ws + WS_CTL);
    for (int u = tid; u < (LDS_BYTES - LDSCTL_OFF) / 4; u += NTHREADS) ((LAS unsigned*)(lds + LDSCTL_OFF))[u] = 0u;
    __syncthreads();
    XcdBarrier bar; bar.bar = (unsigned*)ctl + CW_BAR; bar.x = 0; bar.st = MISC + 8;
    const bool multi = (a.ph_hi - a.ph_lo) > 1;
    if (multi) bar = xcd_barrier_post((unsigned*)ctl + CW_BAR, MISC + 8, tid == 0);
#define IN(k) (a.ph_lo <= (k) && (k) < a.ph_hi)
#define SEAM(k) do { if (IN(k) && IN((k) + 1)) xcd_barrier(bar, opaque_tid() == 0); } while (0)
    const bool psync = PANEL_SYNC && GEMM_FAST && gridDim.x == 256 && multi;
    unsigned* ctlw = (unsigned*)(ws + WS_CTL);
    const int pm_c = 8 * ((int)blockIdx.x & 7) + (((int)blockIdx.x >> 3) & 7);
#define PSEAM(k) do { if (!psync) SEAM(k); } while (0)
#define PANEL_ARRIVE(seam) do { if (psync && opaque_tid() == 0) __hip_atomic_fetch_add(ctlw + CW_PANEL + ((seam) * 64 + pm_c) * 16, 1u, __ATOMIC_RELAXED, __HIP_MEMORY_SCOPE_AGENT); } while (0)
#define PANEL_WAIT(seam) do { if (psync) wait_counter(ctlw + CW_PANEL + ((seam) * 64 + pm_c) * 16, 4u, ctlw + CW_TMO, opaque_tid() == 0); } while (0)
#define META_ARRIVE(seam) do { if (psync) { asm volatile("s_waitcnt vmcnt(0)" ::: "memory"); __syncthreads(); if (opaque_tid() == 0) __hip_atomic_fetch_add(ctlw + CW_METAF + (seam) * 64, 1u, __ATOMIC_RELAXED, __HIP_MEMORY_SCOPE_AGENT); } } while (0)
#define META_WAIT(seam) do { if (psync) wait_counter(ctlw + CW_METAF + (seam) * 64, 8u, ctlw + CW_TMO, opaque_tid() == 0); } while (0)

    float* SS = (float*)(ws + WS_CTL + CTL_SS); float* SSM = (float*)(ws + WS_CTL + CTL_SSM);
    bf16_t* XB = (bf16_t*)(ws + WS_XB); bf16_t* U = (bf16_t*)(ws + WS_U); bf16_t* G = (bf16_t*)(ws + WS_G); bf16_t* YG = (bf16_t*)(ws + WS_YG);
    bf16_t* KB = (bf16_t*)(ws + WS_K); bf16_t* VB = (bf16_t*)(ws + WS_V); float* XFM = (float*)(ws + WS_XFM);

    if (IN(0)) { for (int rep = 0; rep < NREP(0); ++rep) prep_phase(lds, a, wv64_); }
    SEAM(0);
    if (PROBE_PHASE == 100) { for (int rep = 0; rep < PROBE_REP; ++rep) xcd_barrier(bar, opaque_tid() == 0); }
    const int mb8 = (int)gridDim.x >= 64 ? (int)gridDim.x - 8 : 0;
#pragma unroll 1
    for (int l = 0; l < 2; ++l) {
        const int pb = 1 + 3 * l;
        unsigned char* wb = ws + WS_WA + (size_t)l * WA_STRIDE;
        if (IN(pb)) for (int rep = 0; rep < NREP(pb); ++rep) {
            EpiInA E{SS + l * MROWS, SSM + l * 16, U, G};
            if (l == 1 && opaque_bid() < 16) META_WAIT(0);
            if (opaque_bid() < 16) meta_gemm_job(lds, XB + (size_t)MPOS * DM, (const bf16_t*)wb, opaque_bid(), E, wv64_);
            if (l == 1) PANEL_WAIT(0);
#if GEMM_FAST
            { pg8::Gemm g{XB, (const bf16_t*)wb, MROWS, 2048, DM}; pg8::StaticOrder S; S.init(MROWS, 2048, (int)gridDim.x, (int)blockIdx.x);
              pg8::FastInA E2{SS + l * MROWS, ws};
              pg8::gemm_phase<pg8::FastInA, pg8::StaticOrder, true, true>(lds, g, S, E2, wv64_); }
#else
            naive_gemm_phase(lds, XB, (const bf16_t*)wb, 2048, E, wv64_);
#endif
        }
        SEAM(pb);
#if SCAN_FAST
        if (IN(pb + 1)) { for (int rep = 0; rep < NREP(pb + 1); ++rep) scan_phase_fast(lds, a, l, wv64_);
            if (PROBE_PHASE >= 200 && l == 0) { for (int rep = 0; rep < PROBE_REP; ++rep) scan_phase_fast<(PROBE_PHASE >= 200 ? PROBE_PHASE - 200 : 0)>(lds, a, l, wv64_); } }
#else
        if (IN(pb + 1)) { scan_phase_simple(lds, a, l, wv64_); }
#endif
        SEAM(pb + 1);
        if (IN(pb + 2)) for (int rep = 0; rep < NREP(pb + 2); ++rep) {
            const int lastrep = (rep + 1 < NREP(pb + 2)) ? 1 : 0;
            EpiOut E{a.in[I_X], a.out, XFM, XB, SS + (l + 1) * MROWS, SSM + (l + 1) * 16, l == 0 ? 0 : 1};
            if (opaque_bid() >= mb8 && opaque_bid() < mb8 + 8 && !lastrep) { meta_gemm_job(lds, YG + (size_t)MPOS * DM, (const bf16_t*)(wb + WA_WOUT), opaque_bid() - mb8, E, wv64_); META_ARRIVE(l); }
#if GEMM_FAST
            { pg8::Gemm g{YG, (const bf16_t*)(wb + WA_WOUT), MROWS, 1024, DM}; pg8::StaticOrder S; S.init(MROWS, 1024, (int)gridDim.x, (int)blockIdx.x);
              pg8::FastOut E2{a.in[I_X], a.out, XB, SS + (l + 1) * MROWS, l == 0 ? 0 : 1};
              pg8::gemm_phase<pg8::FastOut, pg8::StaticOrder, false, true>(lds, g, S, E2, wv64_);
              PANEL_ARRIVE(l); }
#else
            naive_gemm_phase(lds, YG, (const bf16_t*)(wb + WA_WOUT), 1024, E, wv64_);
#endif
        }
        PSEAM(pb + 2);
    }
    if (IN(7)) for (int rep = 0; rep < NREP(7); ++rep) {
        EpiQKV E{SS + 2 * MROWS, SSM + 2 * 16, a.in[I_KNORM], a.in[I_QNORM], ws, 0};
        if (opaque_bid() < 32) META_WAIT(1);
        if (opaque_bid() < 32) meta_gemm_job(lds, XB + (size_t)MPOS * DM, (const bf16_t*)(ws + WS_WKVQ), opaque_bid(), E, wv64_);
        PANEL_WAIT(1);
        f_phase(a, wv64_);
#if GEMM_FAST
        { pg8::Gemm g{XB, (const bf16_t*)(ws + WS_WKVQ), MROWS, 4096, DM}; pg8::StaticOrder S; S.init(MROWS, 4096, (int)gridDim.x, (int)blockIdx.x);
          pg8::FastQKV E2{SS + 2 * MROWS, a.in[I_KNORM], a.in[I_QNORM], ws, (LAS float*)(lds + EPI_OFF), 0};
          pg8::gemm_phase<pg8::FastQKV, pg8::StaticOrder, true, true>(lds, g, S, E2, wv64_);
          if (PROBE_PHASE == 300) { for (int r2 = 0; r2 < PROBE_REP; ++r2) { pg8::NullEpi E3; pg8::gemm_phase<pg8::NullEpi, pg8::StaticOrder, true, true>(lds, g, S, E3, wv64_); } } }
#else
        naive_gemm_phase(lds, XB, (const bf16_t*)(ws + WS_WKVQ), 4096, E, wv64_);
#endif
    }
    SEAM(7);
#if ATTN_FAST
    if (IN(8)) for (int rep = 0; rep < NREP(8); ++rep) { attn_meta_rows(a, wv64_); attn_phase_fast((char*)lds_raw, a, a.in[I_QNORM], 2 * rep, wv64_); }
#else
    if (IN(8)) { attn_phase_naive(a, wv64_); }
#endif
    SEAM(8);
    if (IN(9)) {
        EpiOut E{a.in[I_X], a.out, XFM, XB, SS + 3 * MROWS, SSM + 3 * 16, 1};
        if (opaque_bid() >= mb8 && opaque_bid() < mb8 + 8) { meta_gemm_job(lds, YG + (size_t)MPOS * DM, (const bf16_t*)(ws + WS_WOUTB), opaque_bid() - mb8, E, wv64_); META_ARRIVE(2); }
#if GEMM_FAST
        { pg8::Gemm g{YG, (const bf16_t*)(ws + WS_WOUTB), MROWS, 1024, DM}; pg8::StaticOrder S; S.init(MROWS, 1024, (int)gridDim.x, (int)blockIdx.x);
          pg8::FastOut E2{a.in[I_X], a.out, XB, SS + 3 * MROWS, 1};
          pg8::gemm_phase<pg8::FastOut, pg8::StaticOrder, false, true>(lds, g, S, E2, wv64_);
          PANEL_ARRIVE(2); }
#else
        naive_gemm_phase(lds, YG, (const bf16_t*)(ws + WS_WOUTB), 1024, E, wv64_);
#endif
    }
    PSEAM(9);
    if (IN(10)) for (int rep = 0; rep < NREP(10); ++rep) {
        EpiQKV E{SS + 3 * MROWS, SSM + 3 * 16, a.in[I_KNORM], a.in[I_QNORM] + HD, ws, 2};
        if (opaque_bid() < 16) META_WAIT(2);
        if (opaque_bid() < 16) meta_gemm_job(lds, XB + (size_t)MPOS * DM, (const bf16_t*)(ws + WS_WINB1), opaque_bid(), E, wv64_);
        PANEL_WAIT(2);
#if GEMM_FAST
        { pg8::Gemm g{XB, (const bf16_t*)(ws + WS_WINB1), MROWS, 2048, DM}; pg8::StaticOrder S; S.init(MROWS, 2048, (int)gridDim.x, (int)blockIdx.x);
          pg8::FastQKV E2{SS + 3 * MROWS, a.in[I_KNORM], a.in[I_QNORM] + HD, ws, (LAS float*)(lds + EPI_OFF), 2};
          pg8::gemm_phase<pg8::FastQKV, pg8::StaticOrder, true, true>(lds, g, S, E2, wv64_); }
#else
        naive_gemm_phase(lds, XB, (const bf16_t*)(ws + WS_WINB1), 2048, E, wv64_);
#endif
    }
    SEAM(10);
#if ATTN_FAST
    if (IN(11)) { attn_meta_rows(a, wv64_); attn_phase_fast((char*)lds_raw, a, a.in[I_QNORM] + HD, 1, wv64_); }
#else
    if (IN(11)) { attn_phase_naive(a, wv64_); }
#endif
    SEAM(11);
    if (IN(12)) {
        EpiOut E{a.in[I_X], a.out, XFM, XB, SS, SSM, 2};
#if GEMM_FAST
        { pg8::Gemm g{YG, (const bf16_t*)(ws + WS_WOUTB) + (size_t)DM * DM, MROWS, 1024, DM}; pg8::StaticOrder S; S.init(MROWS, 1024, (int)gridDim.x, (int)blockIdx.x);
          pg8::FastOut E2{a.in[I_X], a.out, XB, SS, 2};
          pg8::gemm_phase<pg8::FastOut, pg8::StaticOrder, false, true>(lds, g, S, E2, wv64_); }
#else
        naive_gemm_phase(lds, YG, (const bf16_t*)(ws + WS_WOUTB) + (size_t)DM * DM, 1024, E, wv64_);
#endif
    }
#undef IN
#undef SEAM
}

extern "C" void kernel_launch(void* const* d_in, const int* in_sizes, int n_in, void* d_out, int out_size, void* d_ws, size_t ws_size, hipStream_t stream) {
    static int grid = 0;
    if (grid == 0) {
        if (n_in != 20 || out_size != MROWS * DM || ws_size < WS_END) { fprintf(stderr, "kernel_launch: unexpected shapes (n_in %d out %d ws %zu)\n", n_in, out_size, ws_size); grid = -1; return; }
        int dev = 0, cus = 0, per_cu = 0;
        if (hipGetDevice(&dev) != hipSuccess || hipDeviceGetAttribute(&cus, hipDeviceAttributeMultiprocessorCount, dev) != hipSuccess) { grid = -1; return; }
        if (hipFuncSetAttribute((const void*)yoco_fwd, hipFuncAttributeMaxDynamicSharedMemorySize, LDS_BYTES) != hipSuccess) { fprintf(stderr, "kernel_launch: hipFuncSetAttribute failed\n"); grid = -1; return; }
        if (hipOccupancyMaxActiveBlocksPerMultiprocessor(&per_cu, (const void*)yoco_fwd, NTHREADS, LDS_BYTES) != hipSuccess || per_cu < 1) { fprintf(stderr, "kernel_launch: occupancy query says %d blocks per CU\n", per_cu); per_cu = 1; }
        (void)hipGetLastError();
        grid = cus < 256 ? cus : 256;
    }
    if (grid < 0) return;
    (void)hipMemsetAsync((char*)d_ws + WS_CTL, 0, CTL_ZERO_BYTES, stream);
    Args a{};
    for (int i = 0; i < 20; ++i) a.in[i] = (const float*)d_in[i];
    a.out = (float*)d_out; a.ws = (unsigned char*)d_ws;
#if MK_PER_PHASE
    for (int p = 0; p < NPHASES; ++p) { a.ph_lo = p; a.ph_hi = p + 1; hipLaunchKernelGGL(yoco_fwd, dim3(grid), dim3(NTHREADS), LDS_BYTES, stream, a); }
#else
    a.ph_lo = 0; a.ph_hi = NPHASES;
    hipLaunchKernelGGL(yoco_fwd, dim3(grid), dim3(NTHREADS), LDS_BYTES, stream, a);
#endif
}
```

```cpp
#include <hip/hip_runtime.h>
#include <hip/hip_bf16.h>
#include <cstdio>
#include <cstdint>

#define GAS __attribute__((address_space(1)))
#define LAS __attribute__((address_space(3)))
typedef unsigned short bf16_t;
typedef short bf16x8 __attribute__((ext_vector_type(8)));
typedef float f32x4 __attribute__((ext_vector_type(4)));
typedef float f32x2 __attribute__((ext_vector_type(2)));
typedef unsigned u32x4 __attribute__((ext_vector_type(4)));
typedef unsigned u32x2 __attribute__((ext_vector_type(2)));
typedef GAS unsigned gu32;

constexpr int NB = 8, SEQ = 2048, DM = 1024, NMETA = 16, TP = 2112, MPOS = 48, RPOS = 64, MROWS = NB * SEQ;
constexpr int NH = 8, HD = 128;
constexpr float EPS = 1e-6f;
constexpr float SCALE = 0.08838834764831845f;
constexpr int NWAVES = 8, NTHREADS = 512;
constexpr int NPHASES = 13;

#ifndef GEMM_FAST
#define GEMM_FAST 1
#endif
#ifndef ATTN_FAST
#define ATTN_FAST 1
#endif
#ifndef SCAN_FAST
#define SCAN_FAST 1
#endif
#ifndef PROBE_PHASE
#define PROBE_PHASE (-1)
#define PROBE_REP 1
#endif
#define NREP(k) ((k) == PROBE_PHASE ? PROBE_REP : 1)
#ifndef PANEL_SYNC
#define PANEL_SYNC 1
#endif
#ifndef MK_PER_PHASE
#define MK_PER_PHASE 0
#endif

constexpr size_t MiB = 1u << 20;
constexpr size_t WS_CTL = 0, CTL_ZERO_BYTES = 1 * MiB;
constexpr int CW_HQC = 1024, CW_HQS = 2048;
constexpr int CW_PANEL = 10240, CW_METAF = 13312;
constexpr int CW_TMO = 0, CW_CODE = 1, CW_BAR = 4096, CW_Q = 8192;
constexpr size_t CTL_SS = 65536;
constexpr size_t CTL_SSM = CTL_SS + 4 * MROWS * 4;
static_assert(CTL_SSM + 4 * 16 * 4 <= CTL_ZERO_BYTES, "ctl");
constexpr size_t WS_WA = 2 * MiB;
constexpr size_t WA_STRIDE = 7 * MiB, WA_WR = 4 * MiB, WA_WI = 4 * MiB + 512 * 1024, WA_WOUT = 5 * MiB;
constexpr size_t WS_WKVQ = 16 * MiB;
constexpr size_t WS_WINB1 = 24 * MiB;
constexpr size_t WS_WOUTB = 28 * MiB;
constexpr size_t WS_WF = 32 * MiB;
constexpr size_t WS_XFM = 32 * MiB + 65536;
constexpr size_t WS_LS = 33 * MiB;
constexpr size_t ACT_BYTES = (size_t)NB * TP * DM * 2;
constexpr size_t WS_XB = 34 * MiB, WS_U = 67 * MiB, WS_G = 100 * MiB, WS_YG = 133 * MiB, WS_K = 166 * MiB, WS_V = 199 * MiB, WS_END = 232 * MiB;
static_assert(ACT_BYTES == 33 * MiB, "act");

constexpr int RING_BYTES = 131072;
constexpr int EPI_OFF = RING_BYTES, EPI_BYTES = 8192;
constexpr int LDSCTL_OFF = EPI_OFF + EPI_BYTES, MISC_OFF = LDSCTL_OFF + 320;
constexpr int LDS_BYTES = 147456;
static_assert(MISC_OFF + 128 <= LDS_BYTES, "lds");

#define RLX_AGENT __ATOMIC_RELAXED, __HIP_MEMORY_SCOPE_AGENT
#define LDS_WAIT() asm volatile("s_waitcnt lgkmcnt(0)" ::: "memory")
__device__ __forceinline__ unsigned f2bf(float f) { unsigned u = __builtin_bit_cast(unsigned, f); return (u + 0x7fffu + ((u >> 16) & 1u)) >> 16; }
__device__ __forceinline__ unsigned pk2(float lo, float hi) { return f2bf(lo) | (f2bf(hi) << 16); }
__device__ __forceinline__ float bflo(unsigned w) { return __uint_as_float(w << 16); }
__device__ __forceinline__ float bfhi(unsigned w) { return __uint_as_float(w & 0xffff0000u); }
__device__ __forceinline__ float bf2f(bf16_t h) { return __uint_as_float((unsigned)h << 16); }
__device__ __forceinline__ float wave_sum(float v) {
#pragma unroll
    for (int o = 1; o < 64; o <<= 1) v += __shfl_xor(v, o);
    return v;
}
__device__ __forceinline__ float half_sum(float v) {
#pragma unroll
    for (int o = 1; o < 32; o <<= 1) v += __shfl_xor(v, o);
    return v;
}
__device__ __forceinline__ int opaque_tid_(int wv64) { unsigned m = ~0u; asm volatile("" : "+s"(m), "+s"(wv64)); return wv64 + (int)__builtin_amdgcn_mbcnt_hi(m, __builtin_amdgcn_mbcnt_lo(m, 0u)); }
#define opaque_tid() opaque_tid_(wv64_)
__device__ __forceinline__ int opaque_bid() { int b = blockIdx.x; asm volatile("" : "+s"(b)); return b; }
__device__ __forceinline__ float sigmoidf_(float x) { return __builtin_amdgcn_rcpf(1.0f + __builtin_amdgcn_exp2f(-1.4426950408889634f * x)); }
__device__ __forceinline__ int prow(int m) { return (m >> 11) * TP + RPOS + (m & 2047); }

#define XB_TMO      128
#define XB_XCNT(j)  (256  + 64 * (j))
#define XB_XSUB(j)  (1280 + 64 * (j))
#define XB_XGEN(j)  (2304 + 64 * (j))
#define XB_TOP      3328
#define XB_TOPGEN   3392
#define XCD_BAR_WORDS 3456
#define XB_SPIN_CAP (1u << 22)
__device__ __forceinline__ unsigned xb_ld(unsigned* p)              { return __hip_atomic_load(p, __ATOMIC_RELAXED, __HIP_MEMORY_SCOPE_AGENT); }
__device__ __forceinline__ unsigned xb_add(unsigned* p, unsigned v) { return __hip_atomic_fetch_add(p, v, __ATOMIC_RELAXED, __HIP_MEMORY_SCOPE_AGENT); }
__device__ __forceinline__ unsigned xb_xcc_id() { return (unsigned)__builtin_amdgcn_s_getreg((3 << 11) | 20) & 0xFu; }
#define XB_SPIN(cond, bar) do { unsigned _sp = 0; while (cond) { __builtin_amdgcn_s_sleep(1); \
    if ((++_sp & 255u) == 0u) { if (xb_ld(&(bar)[XB_TMO])) break; if (_sp > XB_SPIN_CAP) { atomicAdd(&(bar)[XB_TMO], 1u); break; } } } } while (0)
struct XcdBarrier { unsigned* bar; unsigned x; volatile LAS unsigned* st; };
__device__ __forceinline__ XcdBarrier xcd_barrier_post(unsigned* bar, volatile LAS unsigned* st, bool leader) {
    XcdBarrier b; b.bar = bar; b.x = xb_xcc_id(); b.st = st;
    if (leader) (void)xb_add(&bar[XB_XCNT(b.x)], 1u);
    return b;
}
__device__ __forceinline__ void xcd_barrier_complete(unsigned* bar, unsigned x, unsigned& nloc, unsigned& nx) {
    const unsigned G = gridDim.x * gridDim.y * gridDim.z;
    unsigned sum, cnt, mine, sp = 0u;
    for (;;) {
        sum = 0u; cnt = 0u; mine = 0u;
#pragma unroll
        for (unsigned j = 0; j < 16; ++j) { const unsigned c = xb_ld(&bar[XB_XCNT(j)]); sum += c; cnt += (c > 0u) ? 1u : 0u; mine = (j == x) ? c : mine; }
        if (sum == G) break;
        __builtin_amdgcn_s_sleep(1);
        if ((++sp & 255u) == 0u) { if (xb_ld(&bar[XB_TMO])) break; if (sp > XB_SPIN_CAP) { atomicAdd(&bar[XB_TMO], 1u); break; } }
    }
    nloc = mine > 0u ? mine : 1u; nx = cnt > 0u ? cnt : 1u;
}
__device__ __forceinline__ void xcd_barrier(const XcdBarrier& b, bool leader) {
    asm volatile("s_waitcnt vmcnt(0)" ::: "memory");
    __syncthreads();
    if (leader) {
        unsigned* bar = b.bar;
        __builtin_amdgcn_s_waitcnt(0);
        unsigned nloc = b.st[0], nx = b.st[1];
        if (nloc == 0u) { xcd_barrier_complete(bar, b.x, nloc, nx); b.st[0] = nloc; b.st[1] = nx; }
        const unsigned old = xb_add(&bar[XB_XSUB(b.x)], 1u);
        const unsigned gen = old / nloc;
        if (old + 1u == (gen + 1u) * nloc) {
            __builtin_amdgcn_fence(__ATOMIC_RELEASE, "agent");
            asm volatile("s_waitcnt vmcnt(0)" ::: "memory");
            const unsigned og = xb_add(&bar[XB_TOP], 1u);
            const unsigned tg = og / nx;
            __builtin_amdgcn_fence(__ATOMIC_ACQUIRE, "agent");
            if (og + 1u == (tg + 1u) * nx) xb_add(&bar[XB_TOPGEN], 1u);
            else XB_SPIN(xb_ld(&bar[XB_TOPGEN]) == tg, bar);
            xb_add(&bar[XB_XGEN(b.x)], 1u);
            asm volatile("s_waitcnt vmcnt(0)" ::: "memory");
        } else {
            __builtin_amdgcn_fence(__ATOMIC_ACQUIRE, "agent");
            XB_SPIN(xb_ld(&bar[XB_XGEN(b.x)]) == gen, bar);
            asm volatile("s_waitcnt vmcnt(0)" ::: "memory");
        }
    }
    __syncthreads();
}

struct Args { const float* in[20]; float* out; unsigned char* ws; int ph_lo, ph_hi; };
enum { I_X = 0, I_META, I_ANORM, I_AWIN, I_ACONVW, I_ACONVB, I_AWR, I_ABR, I_AWI, I_ABI, I_ALAM, I_AWOUT, I_KVNORM, I_WKV, I_BF, I_KNORM, I_BNORM, I_BWIN, I_QNORM, I_BWOUT };

__device__ __forceinline__ void wait_counter(unsigned* cnt, unsigned need, unsigned* tmo, bool leader) {
    if (leader) {
        __builtin_amdgcn_fence(__ATOMIC_ACQUIRE, "agent");
        unsigned sp = 0;
        while (__hip_atomic_load(cnt, __ATOMIC_RELAXED, __HIP_MEMORY_SCOPE_AGENT) < need) {
            __builtin_amdgcn_s_sleep(1);
            if ((++sp & 255u) == 0u) { if (__hip_atomic_load(tmo, __ATOMIC_RELAXED, __HIP_MEMORY_SCOPE_AGENT)) break; if (sp > (1u << 22)) { atomicAdd(tmo, 1u); break; } }
        }
        asm volatile("s_waitcnt vmcnt(0)" ::: "memory");
    }
    __syncthreads();
}
struct EpiInA {
    static constexpr int NARROW8 = 0;
    const float* ss; const float* ssm; bf16_t* U; bf16_t* G;
    template <bool META> __device__ __forceinline__ void run(int row, int grp, int l32, f32x4 v) const {
        const float s = META ? ssm[row] : ss[row];
        const float rs = 1.0f / sqrtf(s * (1.0f / DM) + EPS);
        v = v * rs;
        int col = grp * 128 + 4 * l32;
        bf16_t* dst = (col < DM) ? U : G; col &= (DM - 1);
        u32x2 w; w.x = pk2(v[0], v[1]); w.y = pk2(v[2], v[3]);
        if (META) {
#pragma unroll
            for (int b = 0; b < NB; ++b) *(u32x2*)(dst + ((size_t)(b * TP + MPOS + row)) * DM + col) = w;
        } else *(u32x2*)(dst + (size_t)prow(row) * DM + col) = w;
    }
};
struct EpiOut {
    static constexpr int NARROW8 = 1;
    const float* base; float* out; float* xfm; bf16_t* XB; float* ssn; float* ssmn; int mode;
    template <bool META> __device__ __forceinline__ void run(int row, int grp, int l32, f32x4 v) const {
        const int col = grp * 128 + 4 * l32;
        const size_t pr = META ? (size_t)(MPOS + row) : (size_t)prow(row);
        f32x4 b;
        if (META) b = *(const f32x4*)(xfm + (size_t)row * DM + col);
        else if (mode == 0) b = *(const f32x4*)(base + (size_t)row * DM + col);
        else { const u32x2 w = *(const u32x2*)(XB + pr * DM + col); b = (f32x4){bflo(w.x), bfhi(w.x), bflo(w.y), bfhi(w.y)}; }
        const f32x4 x = b + v;
        if (META) *(f32x4*)(xfm + (size_t)row * DM + col) = x;
        if (mode == 2) { if (!META) *(f32x4*)(out + (size_t)row * DM + col) = x; }
        else {
            u32x2 w; w.x = pk2(x[0], x[1]); w.y = pk2(x[2], x[3]);
            if (META) __hip_atomic_store((unsigned long long*)(XB + pr * DM + col), ((unsigned long long)w.y << 32) | w.x, __ATOMIC_RELAXED, __HIP_MEMORY_SCOPE_AGENT);
            else *(u32x2*)(XB + pr * DM + col) = w;
            float q = (x[0] * x[0] + x[1] * x[1]) + (x[2] * x[2] + x[3] * x[3]);
            q = half_sum(q);
            if (l32 == 0) atomicAdd(META ? (ssmn + row) : (ssn + row), q);
        }
    }
    __device__ __forceinline__ void run_meta8(int row, int cb0, int c4, f32x4 v) const {
        const int col = cb0 + 4 * c4;
        const size_t pr = (size_t)(MPOS + row);
        const f32x4 x = *(const f32x4*)(xfm + (size_t)row * DM + col) + v;
        *(f32x4*)(xfm + (size_t)row * DM + col) = x;
        if (mode != 2) {
            u32x2 w; w.x = pk2(x[0], x[1]); w.y = pk2(x[2], x[3]);
            __hip_atomic_store((unsigned long long*)(XB + pr * DM + col), ((unsigned long long)w.y << 32) | w.x, __ATOMIC_RELAXED, __HIP_MEMORY_SCOPE_AGENT);
            float q = (x[0] * x[0] + x[1] * x[1]) + (x[2] * x[2] + x[3] * x[3]);
            q += __shfl_xor(q, 1); q += __shfl_xor(q, 2); q += __shfl_xor(q, 4);
            if (c4 == 0) atomicAdd(ssmn + row, q);
        }
    }
};
struct EpiQKV {
    static constexpr int NARROW8 = 2;
    const float* ss; const float* ssm; const float* knorm; const float* qnorm; unsigned char* ws; int kind_off;
    __device__ __forceinline__ void run_qkv32(LAS unsigned char* lds, int jb, int row, int c4, f32x4 v, int tid, int sm) const {
        const int grp = jb >> 2, kind = kind_off + (grp >> 3), head = grp & 7;
        const size_t boff = kind == 0 ? WS_K : (kind == 1 ? WS_V : (kind == 2 ? WS_U : WS_G));
        bf16_t* dst = (bf16_t*)(ws + boff);
        float* MQ = (float*)(ws + WS_END);
        unsigned* ctlw_ = (unsigned*)(ws + WS_CTL);
        float* hqs = (float*)(ctlw_ + CW_HQS) + (sm * 32 + grp) * 16;
        if (tid < 128) {
            v = v * __builtin_amdgcn_rsqf(ssm[row] * (1.0f / DM) + EPS);
            if (kind == 1 || kind == 3) {
                if (kind == 3) {
#pragma unroll
                    for (int i = 0; i < 4; ++i) v[i] = v[i] * sigmoidf_(v[i]); }
                const int col = head * HD + (jb & 3) * 32 + 4 * c4;
                u32x2 w; w.x = pk2(v[0], v[1]); w.y = pk2(v[2], v[3]);
#pragma unroll
                for (int b = 0; b < NB; ++b) *(u32x2*)(dst + ((size_t)(b * TP + MPOS + row)) * DM + col) = w;
            } else {
                const __amdgpu_buffer_rsrc_t mr = __builtin_amdgcn_make_buffer_rsrc(MQ, (short)0, 16 * 4096 * 4, 0x00020000);
                __builtin_amdgcn_raw_buffer_store_b128((u32x4){__float_as_uint(v[0]), __float_as_uint(v[1]), __float_as_uint(v[2]), __float_as_uint(v[3])}, mr, (unsigned)((row * 4096 + jb * 32 + 4 * c4) * 4), 0, 16);
                float q = (v[0] * v[0] + v[1] * v[1]) + (v[2] * v[2] + v[3] * v[3]);
                q += __shfl_xor(q, 1); q += __shfl_xor(q, 2); q += __shfl_xor(q, 4);
                if (c4 == 0) atomicAdd(hqs + row, q);
            }
        }
        if (kind == 0 || kind == 2) {
            asm volatile("s_waitcnt vmcnt(0)" ::: "memory");
            __syncthreads();
            LAS unsigned* slot = (LAS unsigned*)lds;
            if (tid == 0) { const unsigned old = __hip_atomic_fetch_add(ctlw_ + CW_HQC + sm * 32 + grp, 1u, __ATOMIC_RELAXED, __HIP_MEMORY_SCOPE_AGENT);
                            if (old == 3u) __builtin_amdgcn_fence(__ATOMIC_ACQUIRE, "agent");
                            asm volatile("s_waitcnt vmcnt(0)" ::: "memory"); *slot = old; }
            __syncthreads();
            const unsigned old = *slot;
            __syncthreads();
            if (old == 3u) {
                const int r2 = tid >> 5, l32 = tid & 31;
                const f32x4 x = *(const f32x4*)(MQ + r2 * 4096 + grp * 128 + 4 * l32);
                const float sq = __hip_atomic_load(hqs + r2, __ATOMIC_RELAXED, __HIP_MEMORY_SCOPE_AGENT);
                const f32x4 gw = *(const f32x4*)((kind == 0 ? knorm : qnorm) + 4 * l32);
                const f32x4 y = x * __builtin_amdgcn_rsqf(sq * (1.0f / HD) + EPS) * gw;
                const int col = head * HD + 4 * l32;
                u32x2 w; w.x = pk2(y[0], y[1]); w.y = pk2(y[2], y[3]);
#pragma unroll
                for (int b = 0; b < NB; ++b) *(u32x2*)(dst + ((size_t)(b * TP + MPOS + r2)) * DM + col) = w;
            }
        }
    }
    template <bool META> __device__ __forceinline__ void run(int row, int grp, int l32, f32x4 v) const {
        const float s = META ? ssm[row] : ss[row];
        const float rs = 1.0f / sqrtf(s * (1.0f / DM) + EPS);
        v = v * rs;
        const int kind = kind_off + (grp >> 3), head = grp & 7;
        if (kind == 0 || kind == 2) {
            float q = (v[0] * v[0] + v[1] * v[1]) + (v[2] * v[2] + v[3] * v[3]);
            q = half_sum(q);
            const float inv = 1.0f / sqrtf(q * (1.0f / HD) + EPS);
            const f32x4 g = *(const f32x4*)((kind == 0 ? knorm : qnorm) + 4 * l32);
            v = v * inv * g;
        }
        if (kind == 3) {
#pragma unroll
            for (int i = 0; i < 4; ++i) v[i] = v[i] * sigmoidf_(v[i]);
        }
        const size_t boff = kind == 0 ? WS_K : (kind == 1 ? WS_V : (kind == 2 ? WS_U : WS_G));
        bf16_t* dst = (bf16_t*)(ws + boff);
        const int col = head * HD + 4 * l32;
        u32x2 w; w.x = pk2(v[0], v[1]); w.y = pk2(v[2], v[3]);
        if (META) {
#pragma unroll
            for (int b = 0; b < NB; ++b) *(u32x2*)(dst + ((size_t)(b * TP + MPOS + row)) * DM + col) = w;
        } else *(u32x2*)(dst + (size_t)prow(row) * DM + col) = w;
    }
};

template <class Epi>
__device__ __forceinline__ void naive_gemm_phase(LAS unsigned char* lds, const bf16_t* A, const bf16_t* Bt, int N, const Epi& E, int wv64_) {
    LAS float* As = (LAS float*)lds;
    LAS float* Bs = As + 32 * 33;
    const int tid = opaque_tid(), ty = tid >> 5, tx = tid & 31;
    const int ntn = N / 128, ntiles = (MROWS / 32) * ntn;
    for (int tile = blockIdx.x; tile < ntiles; tile += gridDim.x) {
        const int tm = tile / ntn, tn = tile % ntn;
        float acc[2][4];
#pragma unroll
        for (int i = 0; i < 2; ++i)
#pragma unroll
            for (int j = 0; j < 4; ++j) acc[i][j] = 0.f;
        const int ar = tid >> 4, ac = (tid & 15) * 2;
        const int bn = tid >> 2, bc = (tid & 3) * 8;
        const bf16_t* ap = A + (size_t)prow(tm * 32 + ar) * DM + ac;
        const bf16_t* bp = Bt + (size_t)(tn * 128 + bn) * DM + bc;
        for (int k0 = 0; k0 < DM; k0 += 32) {
            const unsigned aw = *(const unsigned*)(ap + k0);
            const u32x4 bw = *(const u32x4*)(bp + k0);
            __syncthreads();
            As[ar * 33 + ac] = bflo(aw); As[ar * 33 + ac + 1] = bfhi(aw);
            Bs[bn * 33 + bc + 0] = bflo(bw.x); Bs[bn * 33 + bc + 1] = bfhi(bw.x); Bs[bn * 33 + bc + 2] = bflo(bw.y); Bs[bn * 33 + bc + 3] = bfhi(bw.y);
            Bs[bn * 33 + bc + 4] = bflo(bw.z); Bs[bn * 33 + bc + 5] = bfhi(bw.z); Bs[bn * 33 + bc + 6] = bflo(bw.w); Bs[bn * 33 + bc + 7] = bfhi(bw.w);
            __syncthreads();
#pragma unroll 8
            for (int kk = 0; kk < 32; ++kk) {
                const float a0 = As[(2 * ty) * 33 + kk], a1 = As[(2 * ty + 1) * 33 + kk];
#pragma unroll
                for (int j = 0; j < 4; ++j) { const float b = Bs[(4 * tx + j) * 33 + kk]; acc[0][j] += a0 * b; acc[1][j] += a1 * b; }
            }
        }
#pragma unroll
        for (int i = 0; i < 2; ++i) E.template run<false>(tm * 32 + 2 * ty + i, tn, tx, (f32x4){acc[i][0], acc[i][1], acc[i][2], acc[i][3]});
    }
}

namespace pg8 {
constexpr int BM = 256, BK = 64, HALF = 128, HTB = HALF * BK * 2, STAGE_BYTES = 8 * HTB, NXCD = 8, WGM = 8;
__host__ __device__ __forceinline__ int lds_byte(int r, int c) { const int st = (r >> 4) * 2 + (c >> 5), rr = r & 15, cc = c & 31, ob = rr * 64 + cc * 2; return st * 1024 + (ob ^ (((ob >> 9) & 1) << 5)); }
__host__ __device__ __forceinline__ void stage_rc(int b, int& R, int& C) { const int st = b / 1024, sb = b % 1024, swz = sb ^ (((sb >> 9) & 1) << 5); R = (st >> 1) * 16 + swz / 64; C = (st & 1) * 32 + (swz % 64) / 2; }
__host__ __device__ __forceinline__ int perm32(int rho) { const int n = rho >> 4, i = rho & 15; return 8 * (i >> 2) + 4 * n + (i & 3); }
struct Unit { int pm, pn; };
struct Gemm { const bf16_t* A; const bf16_t* Bt; int M, N, K; };
struct StaticOrder {
    int nM, nN, nwg, G, c;
    __host__ __device__ void init(int M, int N, int G_, int c_) { nM = M / BM; nN = N / BM; nwg = nM * nN; G = G_; c = c_; }
    __host__ __device__ bool next(int i, Unit& u) const {
        const long L = (long)i * G + c; if (L >= nwg) return false;
        int wgid = (int)L; { const int q = nwg / NXCD, r = nwg % NXCD, xcd = wgid % NXCD, off = wgid / NXCD; wgid = (xcd < r ? xcd * (q + 1) : r * (q + 1) + (xcd - r) * q) + off; }
        const int nig = WGM * nN, gid = wgid / nig, fm = gid * WGM, gsz = (nM - fm) < WGM ? (nM - fm) : WGM;
        u.pm = fm + ((wgid % nig) % gsz); u.pn = (wgid % nig) / gsz; return true;
    }
    __device__ __forceinline__ void a_ready(const Unit&) const {}
    __device__ __forceinline__ void done(const Unit&) const {}
};
__device__ __forceinline__ unsigned cvt_pk_bf16(float lo, float hi) { unsigned r; asm volatile("v_cvt_pk_bf16_f32 %0, %1, %2" : "=v"(r) : "v"(lo), "v"(hi)); return r; }
__device__ __forceinline__ __amdgpu_buffer_rsrc_t act_rsrc(void* base) { return __builtin_amdgcn_make_buffer_rsrc(base, (short)0, (int)ACT_BYTES, 0x00020000); }
__device__ __forceinline__ void store16_wt(__amdgpu_buffer_rsrc_t rs, size_t byte_off, u32x4 w) { __builtin_amdgcn_raw_buffer_store_b128(w, rs, (unsigned)byte_off, 0, 16); }
__device__ __forceinline__ size_t a_tile_bytes(int pm, int K) { return (size_t)prow(pm * BM) * (size_t)K * 2; }

template <class Epi, class Sched, bool ALIGN_EPI = false, bool SP2 = false>
__device__ __forceinline__ void gemm_phase(LAS unsigned char* lds, const Gemm g, const Sched& S, const Epi& E, int wv64_) {
    const int tid = opaque_tid(), wid = __builtin_amdgcn_readfirstlane(tid >> 6), lane = tid & 63, wr = wid >> 2, wc = wid & 3, fr = lane & 15, fq = lane >> 4;
    const int K = g.K, nt = K / BK;
    unsigned voffA[2], voffB[2];
#pragma unroll
    for (int i = 0; i < 2; ++i) { int R, C; stage_rc(tid * 16 + i * 8192, R, C); const int Rb = Epi::PERM ? ((R & ~31) + perm32(R & 31)) : R;
        voffA[i] = (unsigned)(R * K + C) * 2u; voffB[i] = (unsigned)(Rb * K + C) * 2u; }
    const size_t kstep = (size_t)(BK * 2);
    const size_t hstep = (size_t)HALF * K * 2;
    const size_t tstep = 2 * hstep;
    const unsigned ldsw = (unsigned)wid * 1024u;
    const int aoff = lds_byte(wr * 64 + fr, fq * 8), boff = lds_byte(wc * 32 + fr, fq * 8);
#define PG8_SA(b, h) (((b) * 2 + (h)) * HTB)
#define PG8_SB(b, h) ((4 + (b) * 2 + (h)) * HTB)
#define PG8_STAGE(bufoff, gbase, voff) do { _Pragma("unroll") for (int _i = 0; _i < 2; ++_i) \
        __builtin_amdgcn_global_load_lds((const unsigned*)((const char*)(gbase) + (voff)[_i]), (LAS unsigned*)(lds + (bufoff) + ldsw + _i * 8192), 16, 0, 0); } while (0)
#define PG8_STAGE2(bufoff, gbase, v0_, v1_) do { \
        __builtin_amdgcn_global_load_lds((const unsigned*)((const char*)(gbase) + (v0_)), (LAS unsigned*)(lds + (bufoff) + ldsw), 16, 0, 0); \
        __builtin_amdgcn_global_load_lds((const unsigned*)((const char*)(gbase) + (v1_)), (LAS unsigned*)(lds + (bufoff) + ldsw + 8192), 16, 0, 0); } while (0)
#define PG8_RC(p) ((unsigned)(((p) >> 3) * 262144 + (((p) >> 1) & 3) * 32768 + ((p) & 1) * 256))
#define PG8_RSTAGE(bufoff, p0, gnorm, vnorm) do { if (rl) PG8_STAGE2(bufoff, rbase, rvoff + PG8_RC(p0), rvoff + PG8_RC((p0) + 1)); else PG8_STAGE(bufoff, gnorm, vnorm); } while (0)
#define PG8_LDA(dst, b, h) do { _Pragma("unroll") for (int m = 0; m < 4; ++m) _Pragma("unroll") for (int k = 0; k < 2; ++k) dst[m][k] = *(const LAS bf16x8*)(lds + PG8_SA(b, h) + aoff + m * 2048 + k * 1024); } while (0)
#define PG8_LDB(dst, b, h) do { _Pragma("unroll") for (int n = 0; n < 2; ++n) _Pragma("unroll") for (int k = 0; k < 2; ++k) dst[n][k] = *(const LAS bf16x8*)(lds + PG8_SB(b, h) + boff + n * 2048 + k * 1024); } while (0)
#define PG8_MMA(ai, bj, At, Bt) do { __builtin_amdgcn_s_setprio(1); _Pragma("unroll") for (int m = 0; m < 4; ++m) _Pragma("unroll") for (int n = 0; n < 2; ++n) _Pragma("unroll") for (int k = 0; k < 2; ++k) \
        acc[ai][bj][m][n] = __builtin_amdgcn_mfma_f32_16x16x32_bf16(Bt[n][k], At[m][k], acc[ai][bj][m][n], 0, 0, 0); __builtin_amdgcn_s_setprio(0); } while (0)
#define PG8_WAIT_V(n) asm volatile("s_waitcnt vmcnt(" #n ")" ::: "memory")
#define PG8_WAIT_L(n) asm volatile("s_waitcnt lgkmcnt(" #n ")" ::: "memory")
#define PG8_BAR __builtin_amdgcn_s_barrier()
#define PG8_SCHED __builtin_amdgcn_sched_barrier(0)
    Unit cur, nxt; int ui = 0;
    if (!S.next(0, cur)) return;
    f32x4 acc[2][2][4][2];
#pragma unroll
    for (int a = 0; a < 2; ++a)
#pragma unroll
        for (int b = 0; b < 2; ++b)
#pragma unroll
            for (int m = 0; m < 4; ++m)
#pragma unroll
                for (int n = 0; n < 2; ++n) acc[a][b][m][n] = (f32x4){0.f, 0.f, 0.f, 0.f};
    bf16x8 At[4][2], B0[2][2], B1[2][2];
    const char* cA = (const char*)g.A + a_tile_bytes(cur.pm, K); const char* cB = (const char*)g.Bt + (size_t)cur.pn * tstep;
    S.a_ready(cur);
    if constexpr (SP2) {
        PG8_STAGE(PG8_SB(0, 0), cB, voffB); PG8_STAGE(PG8_SB(0, 1), cB + hstep, voffB); PG8_STAGE(PG8_SA(0, 0), cA, voffA); PG8_STAGE(PG8_SA(0, 1), cA + hstep, voffA);
        if (wr == 1) PG8_BAR;
        PG8_WAIT_V(2); PG8_BAR;
        PG8_STAGE(PG8_SB(1, 0), cB + kstep, voffB); PG8_STAGE(PG8_SA(1, 0), cA + kstep, voffA); PG8_STAGE(PG8_SB(1, 1), cB + hstep + kstep, voffB);
        PG8_WAIT_V(6); PG8_BAR;
    } else {
        PG8_STAGE(PG8_SB(0, 0), cB, voffB); PG8_STAGE(PG8_SA(0, 0), cA, voffA); PG8_STAGE(PG8_SB(0, 1), cB + hstep, voffB); PG8_STAGE(PG8_SA(0, 1), cA + hstep, voffA);
        if (wr == 1) PG8_BAR;
        PG8_WAIT_V(4); PG8_BAR;
        PG8_STAGE(PG8_SB(1, 0), cB + kstep, voffB); PG8_STAGE(PG8_SA(1, 0), cA + kstep, voffA); PG8_STAGE(PG8_SB(1, 1), cB + hstep + kstep, voffB);
        PG8_WAIT_V(6); PG8_BAR;
    }
    bool rok = false; bool rdone = false;
    if constexpr (Epi::RESID) { rok = E.resid_ok(); }
    for (;;) {
        const bool has_next = S.next(ui + 1, nxt);
        if constexpr (Epi::RESID) { rdone = rok && !has_next && SP2; }
        const char* nA = has_next ? (const char*)g.A + a_tile_bytes(nxt.pm, K) : cA; const char* nB = has_next ? (const char*)g.Bt + (size_t)nxt.pn * tstep : cB;
        for (int t = 0; t < nt; t += 2) {
            const bool last = (t == nt - 2);
            const char* a1 = cA + (size_t)(t + 1) * kstep;
            const char* a2 = last ? nA : cA + (size_t)(t + 2) * kstep; const char* b2 = last ? nB : cB + (size_t)(t + 2) * kstep;
            const char* a3 = a2 + kstep; const char* b3 = b2 + kstep;
            if (last && has_next) S.a_ready(nxt);
            if constexpr (SP2) {
            const bool rl = Epi::RESID && last && !has_next && rok;
            const char* rbase = nullptr; unsigned rvoff = 0u;
            if constexpr (Epi::RESID) { if (rl) { rbase = (const char*)E.resid_base();
                const int lane_ = opaque_tid() & 63; rvoff = (unsigned)(((size_t)(prow(cur.pm * BM) + wr * 64 + (lane_ & 15)) * DM + (size_t)cur.pn * BM + wc * 32 + 8 * (lane_ >> 4)) * 2); } }
            PG8_LDB(B0, 0, 0); PG8_LDB(B1, 0, 1); PG8_SCHED; PG8_LDA(At, 0, 0); PG8_STAGE(PG8_SA(1, 1), a1 + hstep, voffA);
            PG8_WAIT_V(8); PG8_WAIT_L(0); PG8_BAR; PG8_MMA(0, 0, At, B0); PG8_MMA(0, 1, At, B1); PG8_BAR; PG8_SCHED;
            PG8_LDA(At, 0, 1); PG8_RSTAGE(PG8_SB(0, 0), 0, b2, voffB); PG8_RSTAGE(PG8_SB(0, 1), 2, b2 + hstep, voffB); PG8_RSTAGE(PG8_SA(0, 0), 4, a2, voffA);
            PG8_WAIT_V(8); PG8_WAIT_L(0); PG8_BAR; PG8_MMA(1, 0, At, B0); PG8_MMA(1, 1, At, B1); PG8_BAR; PG8_SCHED;
            PG8_LDB(B0, 1, 0); PG8_LDB(B1, 1, 1); PG8_SCHED; PG8_LDA(At, 1, 0); PG8_RSTAGE(PG8_SA(0, 1), 6, a2 + hstep, voffA);
            PG8_WAIT_V(8); PG8_WAIT_L(0); PG8_BAR; PG8_MMA(0, 0, At, B0); PG8_MMA(0, 1, At, B1); PG8_BAR; PG8_SCHED;
            PG8_LDA(At, 1, 1); PG8_RSTAGE(PG8_SB(1, 0), 8, b3, voffB); PG8_RSTAGE(PG8_SB(1, 1), 10, b3 + hstep, voffB); PG8_RSTAGE(PG8_SA(1, 0), 12, a3, voffA);
            PG8_WAIT_V(8); PG8_WAIT_L(0); PG8_BAR; PG8_MMA(1, 0, At, B0); PG8_MMA(1, 1, At, B1); PG8_BAR; PG8_SCHED;
            } else {
            PG8_LDB(B0, 0, 0); PG8_SCHED; PG8_LDA(At, 0, 0); PG8_STAGE(PG8_SA(1, 1), a1 + hstep, voffA);
            PG8_WAIT_L(8); PG8_BAR; PG8_WAIT_L(0); PG8_MMA(0, 0, At, B0); PG8_BAR; PG8_SCHED;
            PG8_LDB(B1, 0, 1); PG8_STAGE(PG8_SB(0, 0), b2, voffB);
            PG8_BAR; PG8_WAIT_L(0); PG8_MMA(0, 1, At, B1); PG8_BAR;
            PG8_LDA(At, 0, 1); PG8_STAGE(PG8_SA(0, 0), a2, voffA);
            PG8_BAR; PG8_WAIT_L(0); PG8_MMA(1, 0, At, B0); PG8_BAR; PG8_SCHED;
            PG8_STAGE(PG8_SB(0, 1), b2 + hstep, voffB);
            PG8_WAIT_V(6); PG8_BAR; PG8_MMA(1, 1, At, B1); PG8_BAR;
            PG8_LDB(B0, 1, 0); PG8_SCHED; PG8_LDA(At, 1, 0); PG8_STAGE(PG8_SA(0, 1), a2 + hstep, voffA);
            PG8_WAIT_L(8); PG8_BAR; PG8_WAIT_L(0); PG8_MMA(0, 0, At, B0); PG8_BAR; PG8_SCHED;
            PG8_LDB(B1, 1, 1); PG8_STAGE(PG8_SB(1, 0), b3, voffB);
            PG8_BAR; PG8_WAIT_L(0); PG8_MMA(0, 1, At, B1); PG8_BAR;
            PG8_LDA(At, 1, 1); PG8_STAGE(PG8_SA(1, 0), a3, voffA);
            PG8_BAR; PG8_WAIT_L(0); PG8_MMA(1, 0, At, B0); PG8_BAR; PG8_SCHED;
            PG8_STAGE(PG8_SB(1, 1), b3 + hstep, voffB);
            PG8_WAIT_V(6); PG8_BAR; PG8_MMA(1, 1, At, B1); PG8_BAR;
            }
        }
        if constexpr (ALIGN_EPI) { if (wr == 0) PG8_BAR; }
        E(acc, cur, wr, wc, fr, fq, lds, rdone); S.done(cur);
        if (!has_next) break;
#pragma unroll
        for (int a = 0; a < 2; ++a)
#pragma unroll
            for (int b = 0; b < 2; ++b)
#pragma unroll
                for (int m = 0; m < 4; ++m)
#pragma unroll
                    for (int n = 0; n < 2; ++n) acc[a][b][m][n] = (f32x4){0.f, 0.f, 0.f, 0.f};
        cur = nxt; cA = nA; cB = nB; ++ui;
        if constexpr (ALIGN_EPI) { if (wr == 1) PG8_BAR; }
    }
    PG8_WAIT_V(0);
    if constexpr (!ALIGN_EPI) { if (wr == 0) PG8_BAR; }
    PG8_BAR;
#undef PG8_SA
#undef PG8_SB
#undef PG8_STAGE
#undef PG8_STAGE2
#undef PG8_RSTAGE
#undef PG8_LDA
#undef PG8_LDB
#undef PG8_MMA
#undef PG8_WAIT_V
#undef PG8_WAIT_L
#undef PG8_BAR
#undef PG8_SCHED
}

struct FastInA {
    static constexpr bool PERM = true, RESID = false;
    const float* ss; unsigned char* ws;
    __device__ __forceinline__ void operator()(const f32x4 (&acc)[2][2][4][2], const Unit& u, int wr, int wc, int fr, int fq, LAS unsigned char*, bool) const {
        const int r0 = u.pm * BM + wr * 64 + fr;
        const size_t pr0 = (size_t)prow(u.pm * BM) + wr * 64 + fr;
        bf16_t* dst = (bf16_t*)(ws + (u.pn < 4 ? WS_U : WS_G));
        const int col0 = (u.pn & 3) * BM + wc * 32 + 8 * fq;
        float ssv[2][4];
#pragma unroll
        for (int ai = 0; ai < 2; ++ai)
#pragma unroll
            for (int m = 0; m < 4; ++m) ssv[ai][m] = ss[r0 + ai * HALF + m * 16];
        asm volatile("" ::: "memory");
#pragma unroll
        for (int ai = 0; ai < 2; ++ai)
#pragma unroll
            for (int m = 0; m < 4; ++m) {
                const float rs = __builtin_amdgcn_rsqf(ssv[ai][m] * (1.0f / DM) + EPS);
                bf16_t* rowp = dst + (pr0 + ai * HALF + m * 16) * DM + col0;
#pragma unroll
                for (int bj = 0; bj < 2; ++bj) { const f32x4 v0 = acc[ai][bj][m][0] * rs, v1 = acc[ai][bj][m][1] * rs;
                    u32x4 w; w.x = cvt_pk_bf16(v0[0], v0[1]); w.y = cvt_pk_bf16(v0[2], v0[3]); w.z = cvt_pk_bf16(v1[0], v1[1]); w.w = cvt_pk_bf16(v1[2], v1[3]);
                    *(u32x4*)(rowp + bj * HALF) = w; }
            }
    }
};
struct FastOut {
    static constexpr bool PERM = true, RESID = true;
    const float* base; float* out; bf16_t* XB; float* ssn; int mode;
    __device__ __forceinline__ const bf16_t* resid_base() const { return XB; }
    __device__ __forceinline__ bool resid_ok() const { return mode != 0; }
    static __device__ __forceinline__ constexpr int rslot(int sidx) { return (sidx == 0 ? 4 : sidx == 1 ? 5 : sidx == 2 ? 0 : sidx == 3 ? 1 : sidx == 4 ? 6 : sidx == 5 ? 7 : 2) * HTB; }
    template <int MODE> __device__ __forceinline__ float piece(const f32x4 b0, const f32x4 b1, const f32x4 a0, const f32x4 a1, size_t off, size_t xb_byte, const __amdgpu_buffer_rsrc_t xbr) const {
        const f32x4 x0 = b0 + a0, x1 = b1 + a1;
        if constexpr (MODE == 2) { *(f32x4*)(out + off) = x0; *(f32x4*)(out + off + 4) = x1; return 0.f; }
        else {
            u32x4 w; w.x = cvt_pk_bf16(x0[0], x0[1]); w.y = cvt_pk_bf16(x0[2], x0[3]); w.z = cvt_pk_bf16(x1[0], x1[1]); w.w = cvt_pk_bf16(x1[2], x1[3]);
            store16_wt(xbr, xb_byte, w);
            return (x0[0] * x0[0] + x0[1] * x0[1]) + (x0[2] * x0[2] + x0[3] * x0[3]) + (x1[0] * x1[0] + x1[1] * x1[1]) + (x1[2] * x1[2] + x1[3] * x1[3]);
        }
    }
    template <int MODE> __device__ __forceinline__ void run(const f32x4 (&acc)[2][2][4][2], const Unit& u, int wr, int wc, int fr, int fq, LAS unsigned char* lds, bool pre) const {
        const int r0 = u.pm * BM + wr * 64 + fr;
        const size_t pr0 = (size_t)prow(u.pm * BM) + wr * 64 + fr;
        const int col0 = u.pn * BM + wc * 32 + 8 * fq;
        const __amdgpu_buffer_rsrc_t xbr = act_rsrc(XB);
        if constexpr (MODE != 0) {
            u32x4 res[2][4][2];
            if (pre) {
                asm volatile("s_waitcnt vmcnt(0)" ::: "memory");
                res[1][3][0] = *(const u32x4*)(XB + (pr0 + HALF + 48) * DM + col0); res[1][3][1] = *(const u32x4*)(XB + (pr0 + HALF + 48) * DM + col0 + HALF);
                const LAS unsigned char* lp = lds + (wr * 4 + wc) * 1024 + (fq * 16 + fr) * 16;
#pragma unroll
                for (int p = 0; p < 14; ++p) res[p >> 3][(p >> 1) & 3][p & 1] = *(const LAS u32x4*)(lp + rslot(p >> 1) + (p & 1) * 8192);
            } else {
#pragma unroll
            for (int ai = 0; ai < 2; ++ai)
#pragma unroll
                for (int m = 0; m < 4; ++m)
#pragma unroll
                    for (int bj = 0; bj < 2; ++bj) res[ai][m][bj] = *(const u32x4*)(XB + (pr0 + ai * HALF + m * 16) * DM + col0 + bj * HALF);
            }
            asm volatile("" ::: "memory");
            float qs[2][4];
#pragma unroll
            for (int ai = 0; ai < 2; ++ai)
#pragma unroll
                for (int m = 0; m < 4; ++m) {
                    const int r = r0 + ai * HALF + m * 16;
                    float q = 0.f;
#pragma unroll
                    for (int bj = 0; bj < 2; ++bj) { const u32x4 w = res[ai][m][bj];
                        q += piece<MODE>((f32x4){bflo(w.x), bfhi(w.x), bflo(w.y), bfhi(w.y)}, (f32x4){bflo(w.z), bfhi(w.z), bflo(w.w), bfhi(w.w)}, acc[ai][bj][m][0], acc[ai][bj][m][1],
                                         (size_t)r * DM + col0 + bj * HALF, ((pr0 + ai * HALF + m * 16) * DM + col0 + bj * HALF) * 2, xbr); }
                    qs[ai][m] = q;
                }
            if constexpr (MODE != 2) {
#pragma unroll
                for (int ai = 0; ai < 2; ++ai) {
                    const auto r01 = __builtin_amdgcn_permlane16_swap(__float_as_uint(qs[ai][0]), __float_as_uint(qs[ai][1]), false, false);
                    const auto r23 = __builtin_amdgcn_permlane16_swap(__float_as_uint(qs[ai][2]), __float_as_uint(qs[ai][3]), false, false);
                    const float s01 = __uint_as_float(r01[0]) + __uint_as_float(r01[1]), s23 = __uint_as_float(r23[0]) + __uint_as_float(r23[1]);
                    const auto rt = __builtin_amdgcn_permlane32_swap(__float_as_uint(s01), __float_as_uint(s23), false, false);
                    atomicAdd(ssn + r0 + ai * HALF + fq * 16, __uint_as_float(rt[0]) + __uint_as_float(rt[1]));
                }
            }
        } else {
            f32x4 rbuf[2][2][2][2];
#define FO_LOAD(slot, ai, mp) do { _Pragma("unroll") for (int mm_ = 0; mm_ < 2; ++mm_) _Pragma("unroll") for (int bj_ = 0; bj_ < 2; ++bj_) { \
                const size_t off_ = (size_t)(r0 + (ai) * HALF + (2 * (mp) + mm_) * 16) * DM + col0 + bj_ * HALF; \
                rbuf[slot][mm_][bj_][0] = *(const f32x4*)(base + off_); rbuf[slot][mm_][bj_][1] = *(const f32x4*)(base + off_ + 4); } } while (0)
#define FO_PROC(slot, ai, mp) do { _Pragma("unroll") for (int mm_ = 0; mm_ < 2; ++mm_) { const int m_ = 2 * (mp) + mm_; const int r_ = r0 + (ai) * HALF + m_ * 16; float q_ = 0.f; \
                _Pragma("unroll") for (int bj_ = 0; bj_ < 2; ++bj_) q_ += piece<0>(rbuf[slot][mm_][bj_][0], rbuf[slot][mm_][bj_][1], acc[ai][bj_][m_][0], acc[ai][bj_][m_][1], \
                    (size_t)r_ * DM + col0 + bj_ * HALF, ((pr0 + (ai) * HALF + m_ * 16) * DM + col0 + bj_ * HALF) * 2, xbr); \
                q_ += __shfl_xor(q_, 16); q_ += __shfl_xor(q_, 32); if (fq == 0) atomicAdd(ssn + r_, q_); } } while (0)
#define FO_CB() asm volatile("" ::: "memory")
            FO_LOAD(0, 0, 0); FO_LOAD(1, 0, 1); FO_CB();
            FO_PROC(0, 0, 0); FO_CB(); FO_LOAD(0, 1, 0); FO_CB();
            FO_PROC(1, 0, 1); FO_CB(); FO_LOAD(1, 1, 1); FO_CB();
            FO_PROC(0, 1, 0); FO_CB();
            FO_PROC(1, 1, 1);
#undef FO_LOAD
#undef FO_PROC
#undef FO_CB
        }
    }
    __device__ __forceinline__ void operator()(const f32x4 (&acc)[2][2][4][2], const Unit& u, int wr, int wc, int fr, int fq, LAS unsigned char* lds, bool pre) const {
        if (mode == 0) run<0>(acc, u, wr, wc, fr, fq, lds, false); else if (mode == 1) run<1>(acc, u, wr, wc, fr, fq, lds, pre); else run<2>(acc, u, wr, wc, fr, fq, lds, pre);
    }
};
struct NullEpi {
    static constexpr bool PERM = true, RESID = false;
    __device__ __forceinline__ void operator()(const f32x4 (&acc)[2][2][4][2], const Unit&, int, int, int, int, LAS unsigned char*, bool) const {
#pragma unroll
        for (int ai = 0; ai < 2; ++ai)
#pragma unroll
            for (int bj = 0; bj < 2; ++bj)
#pragma unroll
                for (int m = 0; m < 4; ++m) { asm volatile("" :: "v"(acc[ai][bj][m][0]), "v"(acc[ai][bj][m][1])); }
    }
};
struct FastQKV {
    static constexpr bool PERM = true, RESID = false;
    const float* ss; const float* knorm; const float* qnorm; unsigned char* ws; LAS float* P; int kind_off;
    __device__ __forceinline__ void operator()(const f32x4 (&acc)[2][2][4][2], const Unit& u, int wr, int wc, int fr, int fq, LAS unsigned char*, bool) const {
        const int kind = kind_off + (u.pn >> 2);
        const int r0 = u.pm * BM + wr * 64 + fr;
        const size_t pr0 = (size_t)prow(u.pm * BM) + wr * 64 + fr;
        const size_t boff = kind == 0 ? WS_K : (kind == 1 ? WS_V : (kind == 2 ? WS_U : WS_G));
        bf16_t* dst = (bf16_t*)(ws + boff);
        const int col0 = (u.pn & 3) * BM + wc * 32 + 8 * fq;
        const bool nrm = (kind == 0 || kind == 2);
        f32x4 g0 = (f32x4){1.f, 1.f, 1.f, 1.f}, g1 = g0;
        float ssv[2][4];
#pragma unroll
        for (int ai = 0; ai < 2; ++ai)
#pragma unroll
            for (int m = 0; m < 4; ++m) ssv[ai][m] = ss[r0 + ai * HALF + m * 16];
        if (nrm) {
            const float* gp = (kind == 0 ? knorm : qnorm) + wc * 32 + 8 * fq;
            g0 = *(const f32x4*)gp; g1 = *(const f32x4*)(gp + 4);
#pragma unroll
            for (int ai = 0; ai < 2; ++ai) {
                const float svq = fq == 0 ? ssv[ai][0] : (fq == 1 ? ssv[ai][1] : (fq == 2 ? ssv[ai][2] : ssv[ai][3]));
                const float rs2 = __builtin_amdgcn_rcpf(svq * (1.0f / DM) + EPS);
#pragma unroll
                for (int bj = 0; bj < 2; ++bj) {
                    float qs[4];
#pragma unroll
                    for (int m = 0; m < 4; ++m) { const f32x4 a0 = acc[ai][bj][m][0], a1 = acc[ai][bj][m][1];
                        qs[m] = (a0[0] * a0[0] + a0[1] * a0[1]) + (a0[2] * a0[2] + a0[3] * a0[3]) + (a1[0] * a1[0] + a1[1] * a1[1]) + (a1[2] * a1[2] + a1[3] * a1[3]); }
                    const auto r01 = __builtin_amdgcn_permlane16_swap(__float_as_uint(qs[0]), __float_as_uint(qs[1]), false, false);
                    const auto r23 = __builtin_amdgcn_permlane16_swap(__float_as_uint(qs[2]), __float_as_uint(qs[3]), false, false);
                    const float s01 = __uint_as_float(r01[0]) + __uint_as_float(r01[1]), s23 = __uint_as_float(r23[0]) + __uint_as_float(r23[1]);
                    const auto rt = __builtin_amdgcn_permlane32_swap(__float_as_uint(s01), __float_as_uint(s23), false, false);
                    P[((ai * HALF + wr * 64 + fq * 16 + fr) * 2 + bj) * 4 + wc] = (__uint_as_float(rt[0]) + __uint_as_float(rt[1])) * rs2;
                }
            }
            asm volatile("s_waitcnt lgkmcnt(0)" ::: "memory"); __builtin_amdgcn_s_barrier(); asm volatile("" ::: "memory");
        }
        asm volatile("" ::: "memory");
        if (nrm) tail<1>(acc, ssv, g0, g1, dst, pr0, col0, wr, fr);
        else if (kind == 3) tail<2>(acc, ssv, g0, g1, dst, pr0, col0, wr, fr);
        else tail<0>(acc, ssv, g0, g1, dst, pr0, col0, wr, fr);
    }
    template <int KD> __device__ __forceinline__ void tail(const f32x4 (&acc)[2][2][4][2], const float (&ssv)[2][4], const f32x4 g0, const f32x4 g1, bf16_t* dst, size_t pr0, int col0, int wr, int fr) const {
        f32x4 p4[2][4][2];
        if constexpr (KD == 1) {
#pragma unroll
            for (int ai = 0; ai < 2; ++ai)
#pragma unroll
                for (int m = 0; m < 4; ++m)
#pragma unroll
                    for (int bj = 0; bj < 2; ++bj) p4[ai][m][bj] = *(const LAS f32x4*)(P + ((ai * HALF + wr * 64 + m * 16 + fr) * 2 + bj) * 4);
        }
#pragma unroll
        for (int ai = 0; ai < 2; ++ai)
#pragma unroll
            for (int m = 0; m < 4; ++m) {
                const float rs = __builtin_amdgcn_rsqf(ssv[ai][m] * (1.0f / DM) + EPS);
                bf16_t* rowp = dst + (pr0 + ai * HALF + m * 16) * DM + col0;
#pragma unroll
                for (int bj = 0; bj < 2; ++bj) {
                    float sc = rs;
                    if constexpr (KD == 1) { const f32x4 q4 = p4[ai][m][bj]; sc = rs * __builtin_amdgcn_rsqf(((q4[0] + q4[1]) + (q4[2] + q4[3])) * (1.0f / HD) + EPS); }
                    f32x4 v0 = acc[ai][bj][m][0] * sc, v1 = acc[ai][bj][m][1] * sc;
                    if constexpr (KD == 1) { v0 = v0 * g0; v1 = v1 * g1; }
                    if constexpr (KD == 2) {
#pragma unroll
                        for (int i = 0; i < 4; ++i) { v0[i] = v0[i] * sigmoidf_(v0[i]); v1[i] = v1[i] * sigmoidf_(v1[i]); } }
                    u32x4 w; w.x = cvt_pk_bf16(v0[0], v0[1]); w.y = cvt_pk_bf16(v0[2], v0[3]); w.z = cvt_pk_bf16(v1[0], v1[1]); w.w = cvt_pk_bf16(v1[2], v1[3]);
                    *(u32x4*)(rowp + bj * HALF) = w; }
            }
    }
};
}

template <class Epi>
__device__ __forceinline__ void meta_gemm_job(LAS unsigned char* lds, const bf16_t* A16, const bf16_t* Bt, int grp, const Epi& E, int wv64_) {
    const int tid = opaque_tid(), lane = tid & 63, w = __builtin_amdgcn_readfirstlane(tid >> 6);
    const int fr = lane & 15, fq = lane >> 4;
    f32x4 acc[8];
#pragma unroll
    for (int f = 0; f < 8; ++f) acc[f] = (f32x4){0.f, 0.f, 0.f, 0.f};
    {
        bf16x8 af[4], bfr[4][8];
#pragma unroll
        for (int ks = 0; ks < 4; ++ks) {
            const int k = 128 * w + 32 * ks + 8 * fq;
            af[ks] = *(const bf16x8*)(A16 + (size_t)fr * DM + k);
#pragma unroll
            for (int f = 0; f < 8; ++f) bfr[ks][f] = *(const bf16x8*)(Bt + (size_t)(grp * 128 + 16 * f + fr) * DM + k);
        }
#pragma unroll
        for (int ks = 0; ks < 4; ++ks) { asm volatile("" : "+v"(af[ks]) :: "memory");
#pragma unroll
            for (int f = 0; f < 8; ++f) asm volatile("" : "+v"(bfr[ks][f]) :: "memory"); }
#pragma unroll
        for (int ks = 0; ks < 4; ++ks)
#pragma unroll
            for (int f = 0; f < 8; ++f) acc[f] = __builtin_amdgcn_mfma_f32_16x16x32_bf16(af[ks], bfr[ks][f], acc[f], 0, 0, 0);
    }
    LAS float* P = (LAS float*)lds;
    __syncthreads();
#pragma unroll
    for (int f = 0; f < 8; ++f)
#pragma unroll
        for (int r = 0; r < 4; ++r) P[(w * 16 + 4 * fq + r) * 128 + 16 * f + fr] = acc[f][r];
    __syncthreads();
    const int row = tid >> 5, l32 = tid & 31;
    f32x4 v = (f32x4){0.f, 0.f, 0.f, 0.f};
#pragma unroll
    for (int ww = 0; ww < 8; ++ww) v += *(const LAS f32x4*)(P + (ww * 16 + row) * 128 + 4 * l32);
    __syncthreads();
    E.template run<true>(row, grp, l32, v);
}

template <class Epi>
__device__ __forceinline__ void meta_gemm_job32(LAS unsigned char* lds, const bf16_t* A16, const bf16_t* Bt, int jb, const Epi& E, int wv64_, int sm = 0) {
    const int tid = opaque_tid(), lane = tid & 63, w = __builtin_amdgcn_readfirstlane(tid >> 6);
    const int fr = lane & 15, fq = lane >> 4;
    f32x4 acc[2] = {(f32x4){0.f, 0.f, 0.f, 0.f}, (f32x4){0.f, 0.f, 0.f, 0.f}};
    {
        bf16x8 af[4], bfr[4][2];
#pragma unroll
        for (int ks = 0; ks < 4; ++ks) {
            const int k = 128 * w + 32 * ks + 8 * fq;
            af[ks] = *(const bf16x8*)(A16 + (size_t)fr * DM + k);
#pragma unroll
            for (int f = 0; f < 2; ++f) bfr[ks][f] = *(const bf16x8*)(Bt + (size_t)(jb * 32 + 16 * f + fr) * DM + k);
        }
#pragma unroll
        for (int ks = 0; ks < 4; ++ks) { asm volatile("" : "+v"(af[ks]), "+v"(bfr[ks][0]), "+v"(bfr[ks][1]) :: "memory"); }
#pragma unroll
        for (int ks = 0; ks < 4; ++ks)
#pragma unroll
            for (int f = 0; f < 2; ++f) acc[f] = __builtin_amdgcn_mfma_f32_16x16x32_bf16(af[ks], bfr[ks][f], acc[f], 0, 0, 0);
    }
    LAS float* P = (LAS float*)lds;
    __syncthreads();
#pragma unroll
    for (int f = 0; f < 2; ++f)
#pragma unroll
        for (int r = 0; r < 4; ++r) P[(w * 16 + 4 * fq + r) * 32 + 16 * f + fr] = acc[f][r];
    __syncthreads();
    const int row = (tid >> 3) & 15, c4 = tid & 7;
    f32x4 v = (f32x4){0.f, 0.f, 0.f, 0.f};
#pragma unroll
    for (int ww = 0; ww < 8; ++ww) v += *(const LAS f32x4*)(P + (ww * 16 + row) * 32 + 4 * c4);
    __syncthreads();
    if constexpr (Epi::NARROW8 == 2) E.run_qkv32(lds, jb, row, c4, v, tid, sm);
    else if (tid < 128) { if constexpr (Epi::NARROW8 == 1) E.run_meta8(row, jb * 32, c4, v); else E.template run<true>(row, (jb * 32) >> 7, ((jb * 32) & 127) / 4 + c4, v); }
}

__device__ __forceinline__ void prep_transpose_item(const float* W, int ldw, int col0, const float* g, int K, bf16_t* WT, int row_off, LAS float* scr, int kb, int nb, int lane) {
    const int k0 = 64 * kb, n0 = 32 * nb;
    f32x4 xv[8]; float gs[8];
#pragma unroll
    for (int i = 0; i < 8; ++i) { const int kk = 8 * i + (lane >> 3), n4 = 4 * (lane & 7);
        xv[i] = *(const f32x4*)(W + (size_t)(k0 + kk) * ldw + col0 + n0 + n4); gs[i] = g ? g[k0 + kk] : 1.0f; }
#pragma unroll
    for (int i = 0; i < 8; ++i) asm volatile("" : "+v"(xv[i]), "+v"(gs[i]) :: "memory");
#pragma unroll
    for (int i = 0; i < 8; ++i) { const int kk = 8 * i + (lane >> 3), n4 = 4 * (lane & 7);
        const f32x4 x = xv[i] * gs[i];
        scr[kk * 33 + n4] = x[0]; scr[kk * 33 + n4 + 1] = x[1]; scr[kk * 33 + n4 + 2] = x[2]; scr[kk * 33 + n4 + 3] = x[3]; }
    LDS_WAIT(); asm volatile("" ::: "memory");
    const int c = lane & 7;
#pragma unroll
    for (int j = 0; j < 4; ++j) { const int n = (lane >> 3) + 8 * j; const LAS float* s = scr + (8 * c) * 33 + n;
        u32x4 o; o.x = pk2(s[0 * 33], s[1 * 33]); o.y = pk2(s[2 * 33], s[3 * 33]); o.z = pk2(s[4 * 33], s[5 * 33]); o.w = pk2(s[6 * 33], s[7 * 33]);
        *(u32x4*)(WT + (size_t)(row_off + n0 + n) * K + k0 + 8 * c) = o; }
    LDS_WAIT(); asm volatile("" ::: "memory");
}
__device__ __forceinline__ float row_to_bf16(const float* xrow, bf16_t* orow, float* fcopy, int lane) {
    const f32x4* xr = (const f32x4*)xrow + lane;
    f32x4 v[4]; float s = 0.f;
#pragma unroll
    for (int j = 0; j < 4; ++j) { v[j] = xr[64 * j]; s += (v[j][0] * v[j][0] + v[j][1] * v[j][1]) + (v[j][2] * v[j][2] + v[j][3] * v[j][3]); }
    u32x2* o8 = (u32x2*)orow + lane;
#pragma unroll
    for (int j = 0; j < 4; ++j) { u32x2 w; w.x = pk2(v[j][0], v[j][1]); w.y = pk2(v[j][2], v[j][3]); o8[64 * j] = w; }
    if (fcopy) {
#pragma unroll
        for (int j = 0; j < 4; ++j) ((f32x4*)fcopy + lane)[64 * j] = v[j];
    }
    return wave_sum(s);
}
__device__ __forceinline__ void prep_phase(LAS unsigned char* lds, const Args& a, int wv64_) {
    const int tid = opaque_tid(), lane = tid & 63, wave = __builtin_amdgcn_readfirstlane(tid >> 6);
    const int gw = blockIdx.x * NWAVES + wave, NGW = gridDim.x * NWAVES;
    unsigned char* ws = a.ws;
    LAS float* scr = (LAS float*)(lds + wave * 16384);
    constexpr int I_BIG = (DM / 64) * (2048 / 32);
    constexpr int I_SQ = (DM / 64) * (DM / 32);
    constexpr int I_BLK = (256 / 64) * (256 / 32);
    constexpr int PER_A = I_BIG + I_SQ + 8 * I_BLK;
    constexpr int NITEMS = 2 * PER_A + I_BIG   + I_BIG   + I_BIG   + 2 * I_SQ;
    for (int it = gw; it < NITEMS; it += NGW) {
        int r = it;
        if (r < 2 * PER_A) {
            const int l = r / PER_A; r -= l * PER_A;
            unsigned char* wb = ws + WS_WA + (size_t)l * WA_STRIDE;
            if (r < I_BIG) { prep_transpose_item(a.in[I_AWIN] + (size_t)l * DM * 2048, 2048, 0, a.in[I_ANORM] + l * DM, DM, (bf16_t*)wb, 0, scr, r / 64, r % 64, lane); continue; } r -= I_BIG;
            if (r < I_SQ) { prep_transpose_item(a.in[I_AWOUT] + (size_t)l * DM * DM, DM, 0, nullptr, DM, (bf16_t*)(wb + WA_WOUT), 0, scr, r / 32, r % 32, lane); continue; } r -= I_SQ;
            const int which = r / (4 * I_BLK); r -= which * 4 * I_BLK;
            const int n = r / I_BLK; r -= n * I_BLK;
            const float* W = a.in[which ? I_AWI : I_AWR] + ((size_t)(l * 4 + n)) * 65536;
            prep_transpose_item(W, 256, 0, nullptr, 256, (bf16_t*)(wb + (which ? WA_WI : WA_WR)) + (size_t)n * 65536, 0, scr, r / 8, r % 8, lane); continue;
        }
        r -= 2 * PER_A;
        if (r < I_BIG) { prep_transpose_item(a.in[I_WKV], 2056, 0, a.in[I_KVNORM], DM, (bf16_t*)(ws + WS_WKVQ), 0, scr, r / 64, r % 64, lane); continue; } r -= I_BIG;
        if (r < I_BIG) { prep_transpose_item(a.in[I_BWIN], 2048, 0, a.in[I_BNORM], DM, (bf16_t*)(ws + WS_WKVQ), 2048, scr, r / 64, r % 64, lane); continue; } r -= I_BIG;
        if (r < I_BIG) { prep_transpose_item(a.in[I_BWIN] + (size_t)DM * 2048, 2048, 0, a.in[I_BNORM] + DM, DM, (bf16_t*)(ws + WS_WINB1), 0, scr, r / 64, r % 64, lane); continue; } r -= I_BIG;
        const int j = r / I_SQ; r -= j * I_SQ;
        prep_transpose_item(a.in[I_BWOUT] + (size_t)j * DM * DM, DM, 0, nullptr, DM, (bf16_t*)(ws + WS_WOUTB) + (size_t)j * DM * DM, 0, scr, r / 32, r % 32, lane);
    }
    {
        bf16_t* wf = (bf16_t*)(ws + WS_WF);
        for (int i = blockIdx.x * NTHREADS + tid; i < 16 * DM; i += gridDim.x * NTHREADS) {
            const int h = i >> 10, k = i & 1023;
            wf[i] = (bf16_t)(h < 8 ? f2bf(a.in[I_KVNORM][k] * a.in[I_WKV][(size_t)k * 2056 + 2048 + h]) : 0u);
        }
    }
    float* ss0 = (float*)(ws + WS_CTL + CTL_SS);
    float* ssm0 = (float*)(ws + WS_CTL + CTL_SSM);
    bf16_t* XB = (bf16_t*)(ws + WS_XB);
    if (gw < MROWS) {
        f32x4 cur[4], nxt[4];
#pragma unroll
        for (int j = 0; j < 4; ++j) cur[j] = ((const f32x4*)(a.in[I_X] + (size_t)gw * DM) + lane)[64 * j];
        for (int m = gw; m < MROWS; m += NGW) {
            const int mn = (m + NGW < MROWS) ? m + NGW : m;
#pragma unroll
            for (int j = 0; j < 4; ++j) nxt[j] = ((const f32x4*)(a.in[I_X] + (size_t)mn * DM) + lane)[64 * j];
            asm volatile("" ::: "memory");
            float sq = 0.f;
            u32x2* o8 = (u32x2*)(XB + (size_t)prow(m) * DM) + lane;
#pragma unroll
            for (int j = 0; j < 4; ++j) { const f32x4 v = cur[j]; sq += (v[0] * v[0] + v[1] * v[1]) + (v[2] * v[2] + v[3] * v[3]);
                u32x2 w; w.x = pk2(v[0], v[1]); w.y = pk2(v[2], v[3]); o8[64 * j] = w; }
            sq = wave_sum(sq); if (lane == 0) ss0[m] = sq;
            asm volatile("" ::: "memory");
#pragma unroll
            for (int j = 0; j < 4; ++j) cur[j] = nxt[j];
        }
    }
    for (int i = gw; i < NMETA; i += NGW) { const float s = row_to_bf16(a.in[I_META] + (size_t)i * DM, XB + (size_t)(MPOS + i) * DM, (float*)(ws + WS_XFM) + (size_t)i * DM, lane); if (lane == 0) ssm0[i] = s; }
    {
        static_assert(WS_G == WS_U + ACT_BYTES && WS_YG == WS_G + ACT_BYTES && WS_K == WS_YG + ACT_BYTES && WS_V == WS_K + ACT_BYTES, "contiguous activation buffers");
        for (int r = gw; r < 5 * NB * MPOS; r += NGW) {
            const int bi = r / (NB * MPOS), rr = r % (NB * MPOS), b = rr / MPOS, p = rr % MPOS;
            u32x4* o = (u32x4*)((bf16_t*)(ws + WS_U + (size_t)bi * ACT_BYTES) + (size_t)(b * TP + p) * DM) + lane;
            o[0] = (u32x4){0u, 0u, 0u, 0u}; o[64] = (u32x4){0u, 0u, 0u, 0u};
        }
        float* LS = (float*)(ws + WS_LS);
        for (int i = blockIdx.x * NTHREADS + tid; i < NB * NH * MPOS; i += gridDim.x * NTHREADS) LS[(size_t)(i / MPOS) * TP + (i % MPOS)] = 0.f;
    }
}

__device__ __forceinline__ void scan_phase_simple(LAS unsigned char* lds, const Args& a, int layer, int wv64_) {
    const int tid = opaque_tid();
    unsigned char* ws = a.ws;
    const bf16_t* U = (const bf16_t*)(ws + WS_U); const bf16_t* G = (const bf16_t*)(ws + WS_G); bf16_t* YG = (bf16_t*)(ws + WS_YG);
    LAS float* Wl = (LAS float*)lds;
    LAS float* UC = Wl + 256 * 64;
    LAS float* AB = UC + 32 * 257 + 32;
    for (int unit = blockIdx.x; unit < 256; unit += gridDim.x) {
        const int b = unit & 7, j = unit >> 3, ch0 = 32 * j, blk = j >> 3, kc0 = 256 * blk, oc0 = 32 * (j & 7);
        __syncthreads();
        {
            const float* wr = a.in[I_AWR] + ((size_t)(layer * 4 + blk)) * 65536;
            const float* wi = a.in[I_AWI] + ((size_t)(layer * 4 + blk)) * 65536;
            for (int idx = tid; idx < 256 * 64; idx += NTHREADS) { const int k = idx >> 6, c = idx & 63; Wl[idx] = (c < 32 ? wr : wi)[k * 256 + oc0 + (c & 31)]; }
        }
        const int crow = tid >> 5, cch = (tid & 31) * 8;
        float cw[4][8], cb[8];
#pragma unroll
        for (int i = 0; i < 8; ++i) { cb[i] = a.in[I_ACONVB][layer * DM + kc0 + cch + i];
#pragma unroll
            for (int k = 0; k < 4; ++k) cw[k][i] = a.in[I_ACONVW][(size_t)layer * 4 * DM + k * DM + kc0 + cch + i]; }
        const int grow = tid >> 4, gc = (tid & 15) * 2;
        float br[2], bi[2], L8[2];
#pragma unroll
        for (int e = 0; e < 2; ++e) { const int c = layer * DM + ch0 + gc + e; br[e] = a.in[I_ABR][c]; bi[e] = a.in[I_ABI][c];
            const float lam = a.in[I_ALAM][c]; const float sp = (lam < 0.f ? -lam : 0.f) + log1pf(__expf(-fabsf(lam)));
            L8[e] = -8.0f * sp; }
        float hstate = 0.f;
        for (int tile = 0; tile < TP / 32; ++tile) {
            const int r0 = tile * 32;
#pragma unroll
            for (int h2 = 0; h2 < 2; ++h2) {
                const int rr = crow + 16 * h2, p = r0 + rr;
                float acc[8];
#pragma unroll
                for (int i = 0; i < 8; ++i) acc[i] = cb[i];
#pragma unroll
                for (int k = 0; k < 4; ++k) { const int q = p - 3 + k;
                    if (q >= 0) { const u32x4 w = *(const u32x4*)(U + (size_t)(b * TP + q) * DM + kc0 + cch);
                        acc[0] += cw[k][0] * bflo(w.x); acc[1] += cw[k][1] * bfhi(w.x); acc[2] += cw[k][2] * bflo(w.y); acc[3] += cw[k][3] * bfhi(w.y);
                        acc[4] += cw[k][4] * bflo(w.z); acc[5] += cw[k][5] * bfhi(w.z); acc[6] += cw[k][6] * bflo(w.w); acc[7] += cw[k][7] * bfhi(w.w); } }
#pragma unroll
                for (int i = 0; i < 8; ++i) UC[rr * 257 + cch + i] = acc[i];
            }
            __syncthreads();
            {
                const int p = r0 + grow;
                float ar[2] = {0.f, 0.f}, ai[2] = {0.f, 0.f};
#pragma unroll 8
                for (int k = 0; k < 256; ++k) { const float u = UC[grow * 257 + k];
                    ar[0] += u * Wl[k * 64 + gc]; ar[1] += u * Wl[k * 64 + gc + 1]; ai[0] += u * Wl[k * 64 + 32 + gc]; ai[1] += u * Wl[k * 64 + 32 + gc + 1]; }
#pragma unroll
                for (int e = 0; e < 2; ++e) {
                    const float r = sigmoidf_(ar[e] + br[e]), ig = sigmoidf_(ai[e] + bi[e]);
                    const float la = r * L8[e];
                    const float av = __expf(la);
                    const float mult = sqrtf(fmaxf(-expm1f(2.0f * la), 0.f));
                    const float uu = UC[grow * 257 + oc0 + gc + e];
                    float bv = mult * ig * uu; if (p < MPOS) bv = 0.f;
                    AB[grow * 32 + gc + e] = av; AB[1024 + grow * 32 + gc + e] = bv;
                }
            }
            __syncthreads();
            if (tid < 32) {
                for (int rr = 0; rr < 32; ++rr) { hstate = AB[rr * 32 + tid] * hstate + AB[1024 + rr * 32 + tid]; AB[1024 + rr * 32 + tid] = hstate; }
            }
            __syncthreads();
            {
                const int p = r0 + grow;
                const size_t off = (size_t)(b * TP + p) * DM + ch0 + gc;
                const unsigned gw_ = *(const unsigned*)(G + off);
                const float g0 = bflo(gw_), g1 = bfhi(gw_);
                const float y0 = AB[1024 + grow * 32 + gc] * g0 * sigmoidf_(g0), y1 = AB[1024 + grow * 32 + gc + 1] * g1 * sigmoidf_(g1);
                *(unsigned*)(YG + off) = pk2(y0, y1);
            }
        }
    }
}

namespace scanp {
constexpr int AST = 544, A_BYTES = 64 * AST;
constexpr int L_A = 0, L_UF = 2 * A_BYTES, L_CP = L_UF + 2 * 8192, L_DUMP = L_CP + 2048, L_END = L_DUMP + 4096;
static_assert(L_END <= RING_BYTES, "scan LDS");
}
template <int ABL = 0>
__device__ __forceinline__ void scan_phase_fast(LAS unsigned char* lds, const Args& a, int layer, int wv64_) {
    using namespace scanp;
    const int tid = opaque_tid(), lane = tid & 63, wid = __builtin_amdgcn_readfirstlane(tid >> 6);
    const int fr = lane & 15, fq = lane >> 4, rb = wid >> 1, cb = wid & 1;
    unsigned char* ws = a.ws;
    const bf16_t* U = (const bf16_t*)(ws + WS_U); const bf16_t* G = (const bf16_t*)(ws + WS_G); bf16_t* YG = (bf16_t*)(ws + (ABL ? WS_K : WS_YG));
    for (int unit = blockIdx.x; unit < 256; unit += gridDim.x) {
        const int b = unit & 7, j = unit >> 3, ch0 = 32 * j, blk = j >> 3, kc0 = 256 * blk, oc0 = 32 * (j & 7);
        __syncthreads();
        bf16x8 Br[8], Bi[8];
        {
            const bf16_t* WrT = (const bf16_t*)(ws + WS_WA + (size_t)layer * WA_STRIDE + WA_WR) + (size_t)blk * 65536 + (size_t)(oc0 + 16 * cb + fr) * 256 + 8 * fq;
            const bf16_t* WiT = (const bf16_t*)(ws + WS_WA + (size_t)layer * WA_STRIDE + WA_WI) + (size_t)blk * 65536 + (size_t)(oc0 + 16 * cb + fr) * 256 + 8 * fq;
#pragma unroll
            for (int ks = 0; ks < 8; ++ks) { Br[ks] = *(const bf16x8*)(WrT + 32 * ks); Bi[ks] = *(const bf16x8*)(WiT + 32 * ks); }
        }
        const int chl = layer * DM + ch0 + 16 * cb + fr;
        constexpr float LOG2E = 1.4426950408889634f;
        const float nbr = -LOG2E * a.in[I_ABR][chl], nbi = -LOG2E * a.in[I_ABI][chl];
        float L8v; { const float lam = a.in[I_ALAM][chl]; L8v = -8.0f * ((lam < 0.f ? -lam : 0.f) + log1pf(__expf(-fabsf(lam)))); }
        const float L8l = L8v * LOG2E, L8d = 2.0f * L8v;
        const int cc = tid & 31, rg = tid >> 5;
        f32x2 cw2[4][4], cb2[4];
#pragma unroll
        for (int q = 0; q < 4; ++q) { cb2[q] = *(const f32x2*)(a.in[I_ACONVB] + layer * DM + kc0 + 8 * cc + 2 * q);
#pragma unroll
            for (int k = 0; k < 4; ++k) cw2[k][q] = *(const f32x2*)(a.in[I_ACONVW] + (size_t)layer * 4 * DM + k * DM + kc0 + 8 * cc + 2 * q); }
        const bf16_t* ubase = U + (size_t)(b * TP) * DM + kc0 + 8 * cc;
        u32x4 raw[7];
#define SC_LOAD_RAW(tile) do { _Pragma("unroll") for (int i_ = 0; i_ < 7; ++i_) { int p_ = 64 * (tile) + 4 * rg - 3 + i_; p_ = p_ < 0 ? 0 : p_;     \
            if (ABL & 8) { const unsigned z_ = 0x3f803f80u + (unsigned)(p_ + tid); raw[i_] = (u32x4){z_, z_ + 1u, z_ + 2u, z_ + 3u}; } else raw[i_] = *(const u32x4*)(ubase + (size_t)p_ * DM); } } while (0)
#define SC_STAGE(buf) do { f32x2 c_[4][4]; \
            _Pragma("unroll") for (int rr_ = 0; rr_ < 4; ++rr_) _Pragma("unroll") for (int q_ = 0; q_ < 4; ++q_) c_[rr_][q_] = cb2[q_]; \
            _Pragma("unroll") for (int i_ = 0; i_ < 7; ++i_) { f32x2 u_[4]; u_[0] = (f32x2){bflo(raw[i_].x), bfhi(raw[i_].x)}; u_[1] = (f32x2){bflo(raw[i_].y), bfhi(raw[i_].y)}; \
                u_[2] = (f32x2){bflo(raw[i_].z), bfhi(raw[i_].z)}; u_[3] = (f32x2){bflo(raw[i_].w), bfhi(raw[i_].w)}; \
                _Pragma("unroll") for (int k_ = 0; k_ < 4; ++k_) { if (i_ - k_ >= 0 && i_ - k_ < 4 && (!(ABL & 1) || k_ == 3)) { \
                    _Pragma("unroll") for (int q_ = 0; q_ < 4; ++q_) c_[(i_ - k_) & 3][q_] = cw2[k_][q_] * u_[q_] + c_[(i_ - k_) & 3][q_]; } } } \
            _Pragma("unroll") for (int rr_ = 0; rr_ < 4; ++rr_) { \
                u32x4 o_; o_.x = pg8::cvt_pk_bf16(c_[rr_][0].x, c_[rr_][0].y); o_.y = pg8::cvt_pk_bf16(c_[rr_][1].x, c_[rr_][1].y); o_.z = pg8::cvt_pk_bf16(c_[rr_][2].x, c_[rr_][2].y); o_.w = pg8::cvt_pk_bf16(c_[rr_][3].x, c_[rr_][3].y); \
                *(LAS u32x4*)(lds + L_A + (buf) * A_BYTES + (4 * rg + rr_) * AST + 16 * cc) = o_; \
                } } while (0)
        float h = 0.f;
        SC_LOAD_RAW(0); SC_STAGE(0); SC_LOAD_RAW(1);
        __syncthreads();
        for (int t = 0; t < TP / 64; ++t) {
            const int buf = t & 1;
            unsigned pf = 0u;
            if (wid < 4) { int pr_ = 64 * (t + 4) + (tid >> 2); pr_ = pr_ > TP - 1 ? TP - 1 : pr_; pf = *(const unsigned*)(U + (size_t)(b * TP + pr_) * DM + kc0 + 64 * (tid & 3)); }
            if (t + 1 < TP / 64) SC_STAGE(buf ^ 1);
            const int prow0 = 64 * t + 16 * rb + 4 * fq;
            const size_t goff = (size_t)(b * TP + prow0) * DM + ch0 + 16 * cb + fr;
            bf16_t gv[4];
#pragma unroll
            for (int k = 0; k < 4; ++k) { if (ABL & (8 | 64)) { gv[k] = (bf16_t)0x3f80; } else gv[k] = G[goff + (size_t)k * DM]; }
            asm volatile("" ::: "memory");
            { const int tl_ = t + 2 < TP / 64 ? t + 2 : TP / 64 - 1;
              const bf16_t* up_ = ubase + (size_t)(64 * tl_ + 4 * rg - 3) * DM;
#pragma unroll
              for (int i_ = 0; i_ < 7; ++i_) { if (ABL & 8) { const unsigned z_ = 0x3f803f80u + (unsigned)(i_ + tid); raw[i_] = (u32x4){z_, z_ + 1u, z_ + 2u, z_ + 3u}; } else raw[i_] = *(const u32x4*)(up_ + (size_t)i_ * DM); } }
            f32x4 ar = (f32x4){0.f, 0.f, 0.f, 0.f}, ai = ar;
            {
                const LAS unsigned char* ap = lds + L_A + buf * A_BYTES + (16 * rb + fr) * AST + 16 * fq;
                if (ABL & 2) { const bf16x8 af = *(const LAS bf16x8*)ap; ar = (f32x4){(float)af[0], (float)af[1], (float)af[2], (float)af[3]}; ai = (f32x4){(float)Br[0][0], (float)Bi[0][1], (float)Br[7][2], (float)Bi[7][3]}; }
                else
                {
                    f32x4 ar1 = (f32x4){0.f, 0.f, 0.f, 0.f}, ai1 = ar1;
#pragma unroll
                    for (int ks = 0; ks < 8; ks += 2) { const bf16x8 af0 = *(const LAS bf16x8*)(ap + 64 * ks), af1 = *(const LAS bf16x8*)(ap + 64 * ks + 64);
                        ar = __builtin_amdgcn_mfma_f32_16x16x32_bf16(af0, Br[ks], ar, 0, 0, 0);
                        ai = __builtin_amdgcn_mfma_f32_16x16x32_bf16(af0, Bi[ks], ai, 0, 0, 0);
                        ar1 = __builtin_amdgcn_mfma_f32_16x16x32_bf16(af1, Br[ks + 1], ar1, 0, 0, 0);
                        ai1 = __builtin_amdgcn_mfma_f32_16x16x32_bf16(af1, Bi[ks + 1], ai1, 0, 0, 0); }
                    ar += ar1; ai += ai1;
                }
            }
            float av[4], bv[4];
            {
                const LAS bf16_t* uf = (const LAS bf16_t*)(lds + L_A + buf * A_BYTES + (16 * rb + 4 * fq) * AST) + oc0 + 16 * cb + fr;
#pragma unroll
                for (int k = 0; k < 4; ++k) {
                    if (ABL & 4) { av[k] = 0.5f + 1e-3f * ar[k] + nbr * 1e-9f + L8l * 1e-9f + L8d * 1e-9f; bv[k] = ai[k] * bf2f(uf[k * (AST / 2)]) + nbi * 1e-9f; continue; }
                    const float r = __builtin_amdgcn_rcpf(1.0f + __builtin_amdgcn_exp2f(fmaf(ar[k], -LOG2E, nbr)));
                    const float ig = __builtin_amdgcn_rcpf(1.0f + __builtin_amdgcn_exp2f(fmaf(ai[k], -LOG2E, nbi)));
                    const float avk = __builtin_amdgcn_exp2f(r * L8l);
                    const float em = fmaf(-avk, avk, 1.0f);
                    float bvk = __builtin_amdgcn_sqrtf(em) * ig * bf2f(uf[k * (AST / 2)]);
                    bvk = (prow0 + k < MPOS) ? 0.f : bvk;
                    av[k] = avk; bv[k] = bvk;
                }
            }
            const float P0 = av[0], hl0 = bv[0];
            const float P1 = P0 * av[1], hl1 = av[1] * hl0 + bv[1];
            const float P2 = P1 * av[2], hl2 = av[2] * hl1 + bv[2];
            const float P3 = P2 * av[3], hl3 = av[3] * hl2 + bv[3];
            float A = P3, Bc = hl3;
            const auto sa_ = __builtin_amdgcn_permlane16_swap(__float_as_uint(A), __float_as_uint(A), false, false);
            const auto sb_ = __builtin_amdgcn_permlane16_swap(__float_as_uint(Bc), __float_as_uint(Bc), false, false);
            const float a0_ = __uint_as_float(sa_[0]), a1_ = __uint_as_float(sa_[1]), b0_ = __uint_as_float(sb_[0]), b1_ = __uint_as_float(sb_[1]);
            const float pa_ = a1_ * a0_, pb_ = a1_ * b0_ + b1_;
            const auto ta_ = __builtin_amdgcn_permlane32_swap(__float_as_uint(pa_), __float_as_uint(pa_), false, false);
            const auto tb_ = __builtin_amdgcn_permlane32_swap(__float_as_uint(pb_), __float_as_uint(pb_), false, false);
            const float pa0_ = __uint_as_float(ta_[0]), pa1_ = __uint_as_float(ta_[1]), pb0_ = __uint_as_float(tb_[0]), pb1_ = __uint_as_float(tb_[1]);
            A = pa1_ * pa0_; Bc = pa1_ * pb0_ + pb1_;
            const float ba_ = (fq & 1) ? a0_ : 1.f, bb_ = (fq & 1) ? b0_ : 0.f;
            const float Ae = fq >= 2 ? ba_ * pa0_ : ba_, Be = fq >= 2 ? ba_ * pb0_ + bb_ : bb_;
            LAS f32x2* cp = (LAS f32x2*)(lds + L_CP + buf * 1024);
            { LAS f32x2* cw_ = fq == 3 ? cp + (rb * 2 + cb) * 16 + fr : (LAS f32x2*)(lds + L_DUMP + 2048) + lane; *cw_ = (f32x2){A, Bc}; }
            if (!(ABL & 16)) __syncthreads();
            float hin = h, hout = h;
#pragma unroll
            for (int r2 = 0; r2 < 4; ++r2) { const f32x2 c2 = cp[(r2 * 2 + cb) * 16 + fr]; if (r2 < rb) hin = c2.x * hin + c2.y; hout = c2.x * hout + c2.y; }
            const float hs = Ae * hin + Be;
            const float hk[4] = {P0 * hs + hl0, P1 * hs + hl1, P2 * hs + hl2, P3 * hs + hl3};
#pragma unroll
            for (int k = 0; k < 4; ++k) { const float g = bf2f(gv[k]); const float y = hk[k] * g * __builtin_amdgcn_rcpf(1.0f + __builtin_amdgcn_exp2f(-LOG2E * g));
                if (ABL & (8 | 32)) { asm volatile("" :: "v"(y)); } else YG[goff + (size_t)k * DM] = (bf16_t)pg8::cvt_pk_bf16(y, 0.f); }
            h = hout;
            asm volatile("" :: "v"(pf));
        }
#undef SC_LOAD_RAW
#undef SC_STAGE
    }
}

__device__ __forceinline__ void f_job(const bf16_t* Arows, const bf16_t* WfT, const float* ssrow, const float* b_f, float* LS, int b_lo, int b_hi, int pos0, int lane) {
    const int fr = lane & 15, fq = lane >> 4;
    f32x4 acc = (f32x4){0.f, 0.f, 0.f, 0.f};
#pragma unroll
    for (int h = 0; h < 2; ++h) {
        bf16x8 av[16], bv[16];
#pragma unroll
        for (int i = 0; i < 16; ++i) { const int k = 32 * (16 * h + i) + 8 * fq;
            av[i] = *(const bf16x8*)(Arows + (size_t)fr * DM + k); bv[i] = *(const bf16x8*)(WfT + (size_t)fr * DM + k); }
#pragma unroll
        for (int i = 0; i < 16; ++i) asm volatile("" : "+v"(av[i]), "+v"(bv[i]) :: "memory");
#pragma unroll
        for (int i = 0; i < 16; ++i) acc = __builtin_amdgcn_mfma_f32_16x16x32_bf16(av[i], bv[i], acc, 0, 0, 0);
    }
    if (fr < NH) {
        float ssv[4];
#pragma unroll
        for (int r = 0; r < 4; ++r) ssv[r] = ssrow[4 * fq + r];
        const float bfv = b_f[fr];
        asm volatile("" ::: "memory");
#pragma unroll
        for (int r = 0; r < 4; ++r) { const int row = 4 * fq + r;
            const float rs = 1.0f / sqrtf(ssv[r] * (1.0f / DM) + EPS);
            const float z = acc[r] * rs + bfv;
            const float ls = fminf(z, 0.f) - log1pf(__expf(-fabsf(z)));
            for (int b = b_lo; b < b_hi; ++b) LS[(size_t)(b * NH + fr) * TP + pos0 + row] = ls; }
    }
}
__device__ __forceinline__ void f_phase(const Args& a, int wv64_) {
    const int tid = opaque_tid(), lane = tid & 63, wave = __builtin_amdgcn_readfirstlane(tid >> 6);
    unsigned char* ws = a.ws;
    const bf16_t* XB = (const bf16_t*)(ws + WS_XB); const bf16_t* WfT = (const bf16_t*)(ws + WS_WF);
    const float* ss = (const float*)(ws + WS_CTL + CTL_SS) + 2 * MROWS; const float* ssm = (const float*)(ws + WS_CTL + CTL_SSM) + 2 * 16;
    float* LS = (float*)(ws + WS_LS);
    if ((wave & 1) == 0) {
        if (gridDim.x == 256) {
            const int c = blockIdx.x, pm = 8 * (c & 7) + ((c >> 3) & 7);
            const int m0 = pm * 256 + (c >> 6) * 64 + 16 * (wave >> 1), b = m0 >> 11, t0 = m0 & 2047;
            f_job(XB + (size_t)prow(m0) * DM, WfT, ss + m0, a.in[I_BF], LS, b, b + 1, RPOS + t0, lane);
        } else
        for (int job = blockIdx.x * 4 + (wave >> 1); job < MROWS / 16; job += gridDim.x * 4) {
            const int m0 = job * 16, b = m0 >> 11, t0 = m0 & 2047;
            f_job(XB + (size_t)prow(m0) * DM, WfT, ss + m0, a.in[I_BF], LS, b, b + 1, RPOS + t0, lane);
        }
    } else if (blockIdx.x == 0 && wave == 1) {
        f_job(XB + (size_t)MPOS * DM, WfT, ssm, a.in[I_BF], LS, 0, NB, MPOS, lane);
    }
}

__device__ __forceinline__ void attn_phase_naive(const Args& a, int wv64_) {
    const int tid = opaque_tid(), lane = tid & 63, wave = __builtin_amdgcn_readfirstlane(tid >> 6);
    unsigned char* ws = a.ws;
    const bf16_t* Q = (const bf16_t*)(ws + WS_U); const bf16_t* K = (const bf16_t*)(ws + WS_K); const bf16_t* V = (const bf16_t*)(ws + WS_V);
    const bf16_t* G = (const bf16_t*)(ws + WS_G); bf16_t* YG = (bf16_t*)(ws + WS_YG); const float* LS = (const float*)(ws + WS_LS);
    const int gw = blockIdx.x * NWAVES + wave, NGW = gridDim.x * NWAVES;
    const int total = NB * NH * (TP - MPOS);
    for (int idx = gw; idx < total; idx += NGW) {
        const int pi = idx >> 6, bh = idx & 63, p = MPOS + pi, b = bh >> 3, h = bh & 7;
        const size_t qoff = (size_t)(b * TP + p) * DM + h * HD + 2 * lane;
        const unsigned qw = *(const unsigned*)(Q + qoff);
        const float q0 = bflo(qw), q1 = bfhi(qw);
        const float* ls = LS + (size_t)(b * NH + h) * TP;
        float cs = 0.f; for (int s = MPOS + lane; s <= p; s += 64) cs += ls[s];
        const float Cp = wave_sum(cs);
        float m = -1e30f, l = 0.f, o0 = 0.f, o1 = 0.f, c = 0.f;
        const bf16_t* kp = K + (size_t)(b * TP) * DM + h * HD + 2 * lane; const bf16_t* vp = V + (size_t)(b * TP) * DM + h * HD + 2 * lane;
        for (int s = MPOS; s <= p; ++s) {
            c += ls[s];
            const unsigned kw = *(const unsigned*)(kp + (size_t)s * DM);
            const unsigned vw = *(const unsigned*)(vp + (size_t)s * DM);
            const float dot = wave_sum(q0 * bflo(kw) + q1 * bfhi(kw));
            const float logit = dot * SCALE + (Cp - c);
            const float mn = fmaxf(m, logit), al = __expf(m - mn), pe = __expf(logit - mn);
            l = l * al + pe; o0 = o0 * al + pe * bflo(vw); o1 = o1 * al + pe * bfhi(vw); m = mn;
        }
        const float il = 1.0f / l;
        const unsigned gw_ = *(const unsigned*)(G + qoff);
        const float g0 = bflo(gw_), g1 = bfhi(gw_);
        *(unsigned*)(YG + qoff) = pk2(o0 * il * g0, o1 * il * g1);
    }
}

namespace att {
using bf16 = __hip_bfloat16;
typedef short s16x4 __attribute__((ext_vector_type(4)));
typedef float f32x16 __attribute__((ext_vector_type(16)));
constexpr int NW = 8, QBLK = 32, KVBLK = 64, QB = NW * QBLK, D = 128, RS = DM;
constexpr int SHM_V = KVBLK * D * 2, SHM_K = KVBLK * D * 2;
constexpr int NRING = 3;
constexpr int LDS_WS = NRING * (SHM_V + SHM_K);
constexpr int LDS_BIAS = LDS_WS + NW * 64 * 4;
constexpr int LDS_SCAN = LDS_BIAS + 2 * TP * 4;
constexpr int LDS_TOTAL = LDS_SCAN + 64;
static_assert(LDS_TOTAL <= RING_BYTES, "attention LDS");
constexpr float THR = 8.f;
#define KSWZ(row, colB) ((row) * 256 + ((colB) ^ (((row) & 7) << 4)))
#define SBAR() __builtin_amdgcn_sched_barrier(0)
__device__ __forceinline__ int v_st(int k, int c) { const int kk = (k & ~0xC) | ((k & 4) << 1) | ((k & 8) >> 1); return ((kk >> 3) * 4 + (c >> 5)) * 512 + ((kk & 7) * 32 + (c & 31)) * 2; }
__device__ __forceinline__ int v_rd_base(int lane) { return ((lane & 3) << 3) | (((lane >> 2) & 3) << 6) | (((lane >> 4) & 1) << 5) | (((lane >> 5) & 1) << 8); }
constexpr int v_rd_off(int d0, int ks, int half) { return d0 * 512 + ks * 4096 + half * 2048; }
__device__ __forceinline__ int crow(int r, int hi) { return (r & 3) + 8 * (r >> 2) + 4 * hi; }
__device__ __forceinline__ unsigned cvtpk(float lo, float hi) { unsigned r; asm volatile("v_cvt_pk_bf16_f32 %0, %1, %2" : "=v"(r) : "v"(lo), "v"(hi)); return r; }
__device__ __forceinline__ bf16x8 load8(const bf16* p) { return *reinterpret_cast<const bf16x8*>(p); }
__device__ __forceinline__ void mask_tile(f32x16& p0, f32x16& p1, int dq) {
    const float NEG = -__builtin_inff();
#pragma unroll
    for (int r = 0; r < 16; ++r) {
        const int c = (r & 3) + 8 * (r >> 2);
        if (dq - c < 0) p0[r] = NEG;
        if (dq - c - 32 < 0) p1[r] = NEG;
    }
}
__device__ __forceinline__ void partialSM(f32x16& p0, f32x16& p1, float& m_reg, float& mn, float& alpha) {
    constexpr float C2 = 1.4426950408889634f * SCALE;
    mn = m_reg; alpha = 1.f;
    const float mnL = -mn * C2;
    for (int r = 0; r < 16; ++r) p0[r] = fmaf(p0[r], C2, mnL); for (int r = 0; r < 16; ++r) p1[r] = fmaf(p1[r], C2, mnL);
    for (int r = 0; r < 16; ++r) p0[r] = __builtin_amdgcn_exp2f(p0[r]);
}
__device__ __forceinline__ void finishSM(f32x16& p0, f32x16& p1, float alpha, float& l_reg, bf16x8& pa0, bf16x8& pa1, bf16x8& pa2, bf16x8& pa3) {
    for (int r = 0; r < 16; ++r) p1[r] = __builtin_amdgcn_exp2f(p1[r]);
    float ps = 0; for (int r = 0; r < 16; ++r) ps += p0[r]; for (int r = 0; r < 16; ++r) ps += p1[r];
    { auto rr = __builtin_amdgcn_permlane32_swap(__float_as_uint(ps), __float_as_uint(ps), false, false);
      ps = __uint_as_float(rr[0]) + __uint_as_float(rr[1]); }
    l_reg = l_reg * alpha + ps;
#define PK4(P, B_, OUT) do { unsigned a0 = cvtpk(P[B_+0], P[B_+1]), a1 = cvtpk(P[B_+2], P[B_+3]);                          \
        unsigned b0 = cvtpk(P[B_+4], P[B_+5]), b1 = cvtpk(P[B_+6], P[B_+7]);                                             \
        auto r0 = __builtin_amdgcn_permlane32_swap(a0, b0, false, false); auto r1 = __builtin_amdgcn_permlane32_swap(a1, b1, false, false); \
        u32x4 w = {r0[0], r1[0], r0[1], r1[1]}; OUT = *reinterpret_cast<bf16x8*>(&w); } while (0)
    PK4(p0, 0, pa0); PK4(p0, 8, pa1); PK4(p1, 0, pa2); PK4(p1, 8, pa3);
#undef PK4
}
__device__ __forceinline__ void qkt(int kofs, f32x16& p0, f32x16& p1, const char* K_lds, const LAS float* bt, int r32, int hi, const bf16x8* qr) {
#pragma unroll
    for (int g = 0; g < 4; ++g) { const f32x4 b0 = *(const LAS f32x4*)(bt + 8 * g), b1 = *(const LAS f32x4*)(bt + 32 + 8 * g);
#pragma unroll
        for (int i = 0; i < 4; ++i) { p0[4 * g + i] = b0[i]; p1[4 * g + i] = b1[i]; } }
    const char* kb[4];
#pragma unroll
    for (int dd = 0; dd < 4; ++dd) kb[dd] = K_lds + kofs + KSWZ(r32, (dd * 16 + hi * 8) * 2);
#pragma unroll
    for (int d0 = 0; d0 < 8; ++d0) { const char* a = kb[d0 & 3] + (d0 >> 2) * 128;
        bf16x8 b0 = *reinterpret_cast<const bf16x8*>(a);
        bf16x8 b1 = *reinterpret_cast<const bf16x8*>(a + 32 * 256);
        p0 = __builtin_amdgcn_mfma_f32_32x32x16_bf16(b0, qr[d0], p0, 0, 0, 0);
        p1 = __builtin_amdgcn_mfma_f32_32x32x16_bf16(b1, qr[d0], p1, 0, 0, 0); }
}
__device__ __forceinline__ void pv_tile(f32x16* o, int vb0, bf16x8 pa0, bf16x8 pa1, bf16x8 pa2, bf16x8 pa3) {
#define TRRD(dst, off) asm volatile("ds_read_b64_tr_b16 %0, %1 offset:%2" : "=&v"(dst) : "v"(vb0), "i"(off) : "memory")
#define PV_D0(d0) do { s16x4 l0, l1, l2, l3, h0, h1, h2, h3; constexpr int b_ = v_rd_off(d0, 0, 0); \
        TRRD(l0, b_); TRRD(h0, b_ + 2048); TRRD(l1, b_ + 4096); TRRD(h1, b_ + 6144); TRRD(l2, b_ + 8192); TRRD(h2, b_ + 10240); TRRD(l3, b_ + 12288); TRRD(h3, b_ + 14336); \
        asm volatile("s_waitcnt lgkmcnt(0)" ::: "memory"); SBAR();   \
        o[d0] = __builtin_amdgcn_mfma_f32_32x32x16_bf16(pa0, (bf16x8){l0[0], l0[1], l0[2], l0[3], h0[0], h0[1], h0[2], h0[3]}, o[d0], 0, 0, 0);   \
        o[d0] = __builtin_amdgcn_mfma_f32_32x32x16_bf16(pa1, (bf16x8){l1[0], l1[1], l1[2], l1[3], h1[0], h1[1], h1[2], h1[3]}, o[d0], 0, 0, 0);   \
        o[d0] = __builtin_amdgcn_mfma_f32_32x32x16_bf16(pa2, (bf16x8){l2[0], l2[1], l2[2], l2[3], h2[0], h2[1], h2[2], h2[3]}, o[d0], 0, 0, 0);   \
        o[d0] = __builtin_amdgcn_mfma_f32_32x32x16_bf16(pa3, (bf16x8){l3[0], l3[1], l3[2], l3[3], h3[0], h3[1], h3[2], h3[3]}, o[d0], 0, 0, 0); } while (0)
    PV_D0(0); PV_D0(1); PV_D0(2); PV_D0(3);
#undef PV_D0
#undef TRRD
}
struct BlockRef { unsigned char* ws; int g, t, jlo;
    __device__ __forceinline__ int P0() const { return RPOS + (7 - (t >> 3)) * 256; }
    __device__ __forceinline__ size_t koff() const { return (size_t)(g * TP) * DM + (t & 7) * HD; }
    __device__ __forceinline__ size_t qoff() const { return koff() + (size_t)P0() * DM; }
    __device__ __forceinline__ const bf16* Q() const { return (const bf16*)(ws + WS_U) + qoff(); }
    __device__ __forceinline__ const bf16* K() const { return (const bf16*)(ws + WS_K) + koff(); }
    __device__ __forceinline__ const bf16* V() const { return (const bf16*)(ws + WS_V) + koff(); }
    __device__ __forceinline__ const bf16_t* Gt() const { return (const bf16_t*)(ws + WS_G) + qoff(); }
    __device__ __forceinline__ bf16* O() const { return (bf16*)(ws + WS_YG) + qoff(); } };
struct Seam { bf16x8 qr[8]; bf16x8 st_v0, st_v1, st_k0, st_k1; };
#define ROW(p, k0, rr) ((p) + (size_t)((k0) + (rr)) * RS + sc)
#define VMW() asm volatile("s_waitcnt vmcnt(0)" ::: "memory")
#define VMWN(n) asm volatile("s_waitcnt vmcnt(%0)" :: "i"(n) : "memory")
#define SLOAD_H(Kp, Vp, k0) do { S.st_v0 = load8(ROW(Vp, k0, sr)); S.st_v1 = load8(ROW(Vp, k0, 32 + sr));              \
                         S.st_k0 = load8(ROW(Kp, k0, sr)); S.st_k1 = load8(ROW(Kp, k0, 32 + sr)); } while (0)
#define SWRITE_HK(bf) do { *(bf16x8*)(K_lds + (bf) + kws) = S.st_k0; *(bf16x8*)(K_lds + (bf) + kws + 32 * 256) = S.st_k1; } while (0)
#define SWRITE_HV(bf) do { *(bf16x8*)(V_lds + (bf) + vst0) = S.st_v0; *(bf16x8*)(V_lds + (bf) + vst1) = S.st_v1; } while (0)
#define SWRITE_H(bf) do { SWRITE_HV(bf); SWRITE_HK(bf); } while (0)
__device__ __forceinline__ void prime(const BlockRef& cur, char* lds, Seam& S, int wv64_) {
    const int tid = opaque_tid(), wid = __builtin_amdgcn_readfirstlane(tid >> 6), lane = tid & 63, r32 = lane & 31, hi = lane >> 5;
    const int sr = tid >> 4, sc = (tid & 15) * 8, kws = KSWZ(sr, sc * 2); char* K_lds = lds + NRING * SHM_V;
    for (int d0 = 0; d0 < 8; ++d0) S.qr[d0] = load8(cur.Q() + (size_t)(wid * QBLK + r32) * RS + d0 * 16 + hi * 8);
    SLOAD_H(cur.K(), cur.V(), cur.jlo * KVBLK); VMW(); SWRITE_HK(0);
    __syncthreads();
}
__device__ __forceinline__ void block(const BlockRef& cur, const BlockRef& nxt, int skv, char* lds, const LAS float* biasL, float Bqk, Seam& S, int wv64_) {
    const int tid = opaque_tid(), wid = __builtin_amdgcn_readfirstlane(tid >> 6), lane = tid & 63, r32 = lane & 31, hi = lane >> 5;
    const int P0c = cur.P0();
    int j_hi = (P0c + QB - 1) / KVBLK + 1; if (j_hi > skv / KVBLK) j_hi = skv / KVBLK;
    const int jl = cur.jlo, NT = j_hi - jl;
    const int qlo = P0c + wid * QBLK, qm = qlo + r32 - 4 * hi;
    char* V_lds = lds; char* K_lds = lds + NRING * SHM_V;
    float* ws = (float*)(lds + LDS_WS) + wid * 64; float* li_l = ws, * al_l = ws + 32;
    float m_reg = Bqk + biasL[qlo + r32], l_reg = 0; f32x16 o[4] = {};
    const int sr = tid >> 4, sc = (tid & 15) * 8, vst0 = v_st(sr, sc), vst1 = v_st(32 + sr, sc), kws = KSWZ(sr, sc * 2);
    const int vb0 = (int)(uintptr_t)V_lds + v_rd_base(lane);
    const bf16* Kh = cur.K(); const bf16* Vh = cur.V();
    const LAS float* bh_ = biasL + 4 * hi;
#define RESC(a) do { if (__any((a) < 1.f)) { if (hi == 0) al_l[r32] = (a); asm volatile("s_waitcnt lgkmcnt(0)" ::: "memory");              \
                     for (int d_ = 0; d_ < 4; ++d_) for (int r = 0; r < 16; ++r) o[d_][r] *= al_l[crow(r, hi)]; } } while (0)
#define KBASE(t) ((jl + (t)) * KVBLK)
#define MASKT(P0_, P1_, t) do { const int kb_ = KBASE(t); if (kb_ + KVBLK - 1 > qlo) mask_tile(P0_, P1_, qm - kb_); } while (0)
    constexpr int NQL = 8;
#define SEAM_K0() do { VMWN(NQL); SWRITE_HK(0); SBAR(); } while (0)
    f32x16 pA0, pA1, pB0, pB1; float mnA, mnB, alA, alB; bf16x8 pa0, pa1, pa2, pa3;
    int rc = 0, rp = 0, rn = SHM_K;
#define ROT() do { rp = rc; rc = rn; rn = (rn == (NRING - 1) * SHM_K) ? 0 : rn + SHM_K; } while (0)
    SWRITE_HV(0); SBAR();
    if (NT > 1) { SLOAD_H(Kh, Vh, KBASE(1)); }
    SBAR(); qkt(0, pA0, pA1, K_lds, bh_ + KBASE(0), r32, hi, S.qr);
    MASKT(pA0, pA1, 0); partialSM(pA0, pA1, m_reg, mnA, alA);
    if (NT > 1) { VMW(); SWRITE_H(rn); }
    __syncthreads();
#define HALF_STEP(PX0, PX1, mnX, alX, PY0, PY1, alY, t) do { ROT();                                                           \
        SBAR(); qkt(rc, PX0, PX1, K_lds, bh_ + KBASE(t), r32, hi, S.qr);                                                      \
        finishSM(PY0, PY1, alY, l_reg, pa0, pa1, pa2, pa3); SBAR();                                                           \
        if ((t) + 1 < NT) { SLOAD_H(Kh, Vh, KBASE((t) + 1)); SBAR(); }                                                        \
        pv_tile(o, vb0 + rp, pa0, pa1, pa2, pa3); MASKT(PX0, PX1, (t)); partialSM(PX0, PX1, m_reg, mnX, alX);                 \
        if ((t) + 1 < NT) { VMW(); SWRITE_H(rn); }                                                                            \
        __syncthreads(); } while (0)
    for (int t = 1; t + 1 < NT; t += 2) {
        HALF_STEP(pB0, pB1, mnB, alB, pA0, pA1, alA, t);
        HALF_STEP(pA0, pA1, mnA, alA, pB0, pB1, alB, t + 1);
    }
    const bool even = (NT & 1) == 0;
    if (even) { ROT(); SBAR(); qkt(rc, pB0, pB1, K_lds, bh_ + KBASE(NT - 1), r32, hi, S.qr); SBAR(); }
    SLOAD_H(nxt.K(), nxt.V(), nxt.jlo * KVBLK); SBAR();
    { const bf16* nq_ = nxt.Q() + (size_t)(wid * QBLK + r32) * RS + hi * 8;
#pragma unroll
    for (int d0 = 0; d0 < 8; ++d0) S.qr[d0] = load8(nq_ + d0 * 16); }
    SBAR();
    finishSM(pA0, pA1, alA, l_reg, pa0, pa1, pa2, pa3); SBAR();
    pv_tile(o, vb0 + (even ? rp : rc), pa0, pa1, pa2, pa3);
    if (even) { MASKT(pB0, pB1, NT - 1); partialSM(pB0, pB1, m_reg, mnB, alB); __syncthreads();
        finishSM(pB0, pB1, alB, l_reg, pa0, pa1, pa2, pa3); SBAR(); pv_tile(o, vb0 + rc, pa0, pa1, pa2, pa3); }
    __syncthreads();
#undef ROT
    SBAR(); SEAM_K0();
    if (hi == 0) li_l[r32] = l_reg; asm volatile("s_waitcnt lgkmcnt(0)" ::: "memory");
    float rli[16];
#pragma unroll
    for (int r = 0; r < 16; ++r) rli[r] = __builtin_amdgcn_rcpf(li_l[crow(r, hi)]);
    bf16* Ow = cur.O() + (size_t)(wid * QBLK) * RS; const bf16_t* Gw = cur.Gt() + (size_t)(wid * QBLK) * RS;
    u32x4 gvv[8];
#pragma unroll
    for (int i = 0; i < 8; ++i) gvv[i] = *(const u32x4*)(Gw + (size_t)(4 * i + (lane >> 4)) * RS + (lane & 15) * 8);
    asm volatile("" ::: "memory");
    { LAS unsigned char* stg = (LAS unsigned char*)(wid < 4 ? V_lds + SHM_V + wid * 8192 : K_lds + SHM_K + (wid - 4) * 8192);
#pragma unroll
      for (int r = 0; r < 16; ++r) { const int orow = crow(r, hi);
#pragma unroll
        for (int d0 = 0; d0 < 4; ++d0) { const float v = o[d0][r] * rli[r];
            const float vn = __uint_as_float((unsigned)__builtin_amdgcn_update_dpp(0, (int)__float_as_uint(v), 0xB1, 0xF, 0xF, false));
            const bool odd_ = (r32 & 1) != 0;
            *(LAS unsigned*)(stg + orow * 256 + (d0 * 32 + (r32 & ~1)) * 2) = cvtpk(odd_ ? vn : v, odd_ ? v : vn); } }
      asm volatile("s_waitcnt lgkmcnt(0)" ::: "memory");
#pragma unroll
      for (int i = 0; i < 8; ++i) { const int row = 4 * i + (lane >> 4), ch = lane & 15;
          const u32x4 ov = *(const LAS u32x4*)(stg + row * 256 + ch * 16);
          const u32x4 gv = gvv[i];
          u32x4 w; w.x = cvtpk(bflo(ov.x) * bflo(gv.x), bfhi(ov.x) * bfhi(gv.x)); w.y = cvtpk(bflo(ov.y) * bflo(gv.y), bfhi(ov.y) * bfhi(gv.y));
          w.z = cvtpk(bflo(ov.z) * bflo(gv.z), bfhi(ov.z) * bfhi(gv.z)); w.w = cvtpk(bflo(ov.w) * bflo(gv.w), bfhi(ov.w) * bfhi(gv.w));
          *(u32x4*)(Ow + (size_t)row * RS + ch * 8) = w; } }
    __syncthreads();
#undef RESC
#undef KBASE
#undef MASKT
#undef SEAM_K0
#undef HALF_STEP
}
#undef ROW
#undef VMW
#undef VMWN
#undef SLOAD_H
#undef SWRITE_HK
#undef SWRITE_HV
#undef SWRITE_H
#undef KSWZ
#undef SBAR
__device__ __forceinline__ int make_bias(char* lds, const float* ls, int sel, int P0, int wv64_) {
    const int tid = opaque_tid(), lane = tid & 63, wid = tid >> 6;
    LAS float* biasL = (LAS float*)((LAS unsigned char*)lds + LDS_BIAS) + sel * TP; LAS float* tot = (LAS float*)((LAS unsigned char*)lds + LDS_SCAN);
    float v[8]; float run = 0.f;
    if (tid < TP / 8) { const f32x4 a0 = *(const f32x4*)(ls + 8 * tid), a1 = *(const f32x4*)(ls + 8 * tid + 4);
        v[0] = a0[0]; v[1] = a0[1]; v[2] = a0[2]; v[3] = a0[3]; v[4] = a1[0]; v[5] = a1[1]; v[6] = a1[2]; v[7] = a1[3]; }
    else {
#pragma unroll
        for (int e = 0; e < 8; ++e) v[e] = 0.f; }
#pragma unroll
    for (int e = 0; e < 8; ++e) { run += v[e]; v[e] = run; }
    float inc = run;
#pragma unroll
    for (int o = 1; o < 64; o <<= 1) { const float t = __uint_as_float(__builtin_amdgcn_ds_bpermute(4 * (lane - o), __float_as_uint(inc))); if (lane >= o) inc += t; }
    if (lane == 63) tot[wid] = inc;
    __syncthreads();
    float base = inc - run;
    for (int w = 0; w < wid; ++w) base += tot[w];
    if (tid < TP / 8) {
#pragma unroll
        for (int e = 0; e < 8; ++e) { const int pos = 8 * tid + e; biasL[pos] = pos < MPOS ? -__builtin_inff() : -(base + v[e]) * (1.0f / SCALE); } }
    __syncthreads();
    if (tid < 64) {
        const int kt = tid < TP / KVBLK ? tid : TP / KVBLK - 1;
        const bool live = (biasL[KVBLK * kt + KVBLK - 1] - biasL[P0]) * (1.4426950408889634f * SCALE) >= -160.0f;
        const unsigned long long m = __ballot(live && tid < TP / KVBLK);
        if (tid == 0) ((LAS int*)tot)[15] = m ? (int)__builtin_ctzll(m) : 0;
    }
    __syncthreads();
    const int jlo = __builtin_amdgcn_readfirstlane(((LAS int*)tot)[15]);
    return jlo;
}
__device__ __forceinline__ int next_ticket(char* lds, unsigned* counter, int wv64_) {
    LAS int* slot = (LAS int*)((LAS unsigned char*)lds + LDS_SCAN) + 14;
    if (opaque_tid() == 0) *slot = (int)__hip_atomic_fetch_add(counter, 1u, __ATOMIC_RELAXED, __HIP_MEMORY_SCOPE_AGENT);
    __syncthreads();
    const int t = __builtin_amdgcn_readfirstlane(*slot);
    __syncthreads();
    return t;
}
}

__device__ __forceinline__ void attn_phase_fast(char* lds, const Args& a, const float* qnorm, int qsel, int wv64_) {
    unsigned char* ws = a.ws;
    const float* LS = (const float*)(ws + WS_LS);
    const int G_ = gridDim.x, bx = blockIdx.x;
    const int vcu = (G_ % 8 == 0) ? (bx % 8) * (G_ / 8) + bx / 8 : bx;
    const LAS float* biasL = (const LAS float*)((LAS unsigned char*)lds + att::LDS_BIAS);
    float Bqk;
    { const int lane = opaque_tid() & 63; float mq = fmaxf(fabsf(qnorm[lane]), fabsf(qnorm[lane + 64])), mk = fmaxf(fabsf(a.in[I_KNORM][lane]), fabsf(a.in[I_KNORM][lane + 64]));
#pragma unroll
      for (int o = 1; o < 64; o <<= 1) { mq = fmaxf(mq, __shfl_xor(mq, o)); mk = fmaxf(mk, __shfl_xor(mk, o)); }
      Bqk = (float)HD * mq * mk * 1.0001f; }
    const int g = bx & 7;
    unsigned* counter = (unsigned*)(ws + WS_CTL) + CW_Q + (qsel * 8 + g) * 64;
    (void)vcu;
#define ATT_REF(R, t_, jlo_) do { R.ws = ws; R.g = g; R.t = (t_); R.jlo = (jlo_); } while (0)
    static constexpr unsigned char UNIT_ORDER[64] = {4, 5, 6, 7, 3, 11, 12, 13, 14, 15, 19, 20, 21, 22, 23, 27, 28, 29, 30, 31, 2, 10, 18, 26, 34, 35, 36, 37, 38, 39, 42, 43,
                                                     44, 45, 46, 47, 1, 9, 17, 25, 33, 41, 0, 8, 16, 24, 32, 40, 48, 49, 50, 51, 52, 53, 54, 55, 56, 57, 58, 59, 60, 61, 62, 63};
#define ATT_UNIT(tk) ((int)UNIT_ORDER[(tk) & 63])
    static constexpr unsigned char UNIT_BIN[96] = {9, 0, 50, 45, 49, 54, 42, 48, 51, 44, 47, 60, 46, 43, 62, 36, 53, 58, 37, 34, 255, 39, 18, 255, 35, 26, 255, 19, 1, 255, 3, 25, 255, 38, 2, 255, 27, 41, 255, 11, 33, 255,
        17, 55, 52, 10, 32, 61, 6, 255, 255, 7, 255, 255, 5, 255, 255, 31, 8, 255, 30, 24, 255, 29, 16, 255, 28, 40, 255, 22, 56, 255, 20, 57, 255, 21, 63, 255, 23, 59, 255, 14, 255, 255, 4, 255, 255, 13, 255, 255, 12, 255, 255, 15, 255, 255};
    const bool paired = (((G_ - g + 7) >> 3) == 32);
    int t0 = att::next_ticket(lds, counter, wv64_);
    const int tk0 = t0;
    int nfetch = 0;
    if (t0 < 64) {
        int sel = 0;
        att::BlockRef cur, nxt;
        t0 = (paired && tk0 < 32) ? (int)UNIT_BIN[3 * tk0] : ATT_UNIT(t0);
        { const int jl = att::make_bias(lds, LS + (size_t)(g * NH + (t0 & 7)) * TP, sel, RPOS + (7 - (t0 >> 3)) * 256, wv64_); ATT_REF(cur, t0, jl); }
        att::Seam S;
        att::prime(cur, lds, S, wv64_);
        for (;;) {
            ++nfetch;
            int t1;
            if (paired) t1 = (nfetch < 3 && tk0 < 32) ? (int)UNIT_BIN[3 * tk0 + nfetch] : 255;
            else { t1 = att::next_ticket(lds, counter, wv64_); t1 = t1 < 64 ? ATT_UNIT(t1) : 255; }
            const bool more = t1 < 64;
            if (more) { const int jl = att::make_bias(lds, LS + (size_t)(g * NH + (t1 & 7)) * TP, sel ^ 1, RPOS + (7 - (t1 >> 3)) * 256, wv64_); ATT_REF(nxt, t1, jl); }
            else nxt = cur;
            att::block(cur, nxt, TP, lds, biasL + sel * TP, Bqk, S, wv64_);
            if (!more) break;
            cur = nxt; sel ^= 1;
        }
    }
#undef ATT_REF
#undef ATT_UNIT
}
__device__ __forceinline__ void attn_meta_rows(const Args& a, int wv64_) {
    const int tid = opaque_tid(), lane = tid & 63, wave = __builtin_amdgcn_readfirstlane(tid >> 6);
    if (opaque_bid() >= NMETA) return;
    unsigned char* ws = a.ws;
    const bf16_t* Q = (const bf16_t*)(ws + WS_U); const bf16_t* K = (const bf16_t*)(ws + WS_K); const bf16_t* V = (const bf16_t*)(ws + WS_V);
    const bf16_t* G = (const bf16_t*)(ws + WS_G); bf16_t* YG = (bf16_t*)(ws + WS_YG); const float* LS = (const float*)(ws + WS_LS);
    const int p = MPOS + opaque_bid(), h = wave, np = p - MPOS + 1;
    const size_t qoff = (size_t)p * DM + h * HD + 2 * lane;
    const unsigned qw = *(const unsigned*)(Q + qoff);
    const unsigned gw_ = *(const unsigned*)(G + qoff);
    const float q0 = bflo(qw), q1 = bfhi(qw);
    const float* ls = LS + (size_t)h * TP + MPOS;
    unsigned kw[NMETA], vw[NMETA]; float lsv[NMETA], dot[NMETA];
#pragma unroll
    for (int s = 0; s < NMETA; ++s) { const int sc = s < np ? s : np - 1; const size_t ko = (size_t)(MPOS + sc) * DM + h * HD + 2 * lane;
        kw[s] = *(const unsigned*)(K + ko); vw[s] = *(const unsigned*)(V + ko); lsv[s] = ls[sc]; }
#pragma unroll
    for (int s = 0; s < NMETA; ++s) dot[s] = q0 * bflo(kw[s]) + q1 * bfhi(kw[s]);
#pragma unroll
    for (int o = 1; o < 64; o <<= 1) {
#pragma unroll
        for (int s = 0; s < NMETA; ++s) dot[s] += __shfl_xor(dot[s], o);
    }
    float Cp = 0.f;
#pragma unroll
    for (int s = 0; s < NMETA; ++s) Cp += (s < np) ? lsv[s] : 0.f;
    float logit[NMETA], c = 0.f, m = -1e30f;
#pragma unroll
    for (int s = 0; s < NMETA; ++s) { c += lsv[s]; logit[s] = (s < np) ? dot[s] * SCALE + (Cp - c) : -1e30f; m = fmaxf(m, logit[s]); }
    float l = 0.f, o0 = 0.f, o1 = 0.f;
#pragma unroll
    for (int s = 0; s < NMETA; ++s) { const float pe = (s < np) ? __expf(logit[s] - m) : 0.f; l += pe; o0 += pe * bflo(vw[s]); o1 += pe * bfhi(vw[s]); }
    const float il = 1.0f / l;
    *(unsigned*)(YG + qoff) = pk2(o0 * il * bflo(gw_), o1 * il * bfhi(gw_));
}

__global__ void __launch_bounds__(NTHREADS, 2) yoco_fwd(Args a) {
    extern __shared__ __attribute__((aligned(16))) unsigned char lds_raw[];
    LAS unsigned char* lds = (LAS unsigned char*)lds_raw;
    volatile LAS unsigned* MISC = (volatile LAS unsigned*)(lds + MISC_OFF);
    const int wv64_ = __builtin_amdgcn_readfirstlane(threadIdx.x >> 6) << 6;
    const int tid = opaque_tid();
    unsigned char* ws = a.ws;
    gu32* ctl = (gu32*)(ws + WS_CTL);
    for (int u = tid; u < (LDS_BYTES - LDSCTL_OFF) / 4; u += NTHREADS) ((LAS unsigned*)(lds + LDSCTL_OFF))[u] = 0u;
    __syncthreads();
    XcdBarrier bar; bar.bar = (unsigned*)ctl + CW_BAR; bar.x = 0; bar.st = MISC + 8;
    const bool multi = (a.ph_hi - a.ph_lo) > 1;
    if (multi) bar = xcd_barrier_post((unsigned*)ctl + CW_BAR, MISC + 8, tid == 0);
#define IN(k) (a.ph_lo <= (k) && (k) < a.ph_hi)
#define SEAM(k) do { if (IN(k) && IN((k) + 1)) xcd_barrier(bar, opaque_tid() == 0); } while (0)
    const bool psync = PANEL_SYNC && GEMM_FAST && gridDim.x == 256 && multi;
    unsigned* ctlw = (unsigned*)(ws + WS_CTL);
    const int pm_c = 8 * ((int)blockIdx.x & 7) + (((int)blockIdx.x >> 3) & 7);
#define PSEAM(k) do { if (!psync) SEAM(k); } while (0)
#define PANEL_ARRIVE(seam) do { if (psync && opaque_tid() == 0) __hip_atomic_fetch_add(ctlw + CW_PANEL + ((seam) * 64 + pm_c) * 16, 1u, __ATOMIC_RELAXED, __HIP_MEMORY_SCOPE_AGENT); } while (0)
#define PANEL_WAIT(seam) do { if (psync) wait_counter(ctlw + CW_PANEL + ((seam) * 64 + pm_c) * 16, 4u, ctlw + CW_TMO, opaque_tid() == 0); } while (0)
#define META_ARRIVE(seam) do { if (psync) { asm volatile("s_waitcnt vmcnt(0)" ::: "memory"); __syncthreads(); if (opaque_tid() == 0) __hip_atomic_fetch_add(ctlw + CW_METAF + (seam) * 64, 1u, __ATOMIC_RELAXED, __HIP_MEMORY_SCOPE_AGENT); } } while (0)
#define META_WAIT(seam) do { if (psync) wait_counter(ctlw + CW_METAF + (seam) * 64, 32u, ctlw + CW_TMO, opaque_tid() == 0); } while (0)

    float* SS = (float*)(ws + WS_CTL + CTL_SS); float* SSM = (float*)(ws + WS_CTL + CTL_SSM);
    bf16_t* XB = (bf16_t*)(ws + WS_XB); bf16_t* U = (bf16_t*)(ws + WS_U); bf16_t* G = (bf16_t*)(ws + WS_G); bf16_t* YG = (bf16_t*)(ws + WS_YG);
    bf16_t* KB = (bf16_t*)(ws + WS_K); bf16_t* VB = (bf16_t*)(ws + WS_V); float* XFM = (float*)(ws + WS_XFM);

    if (IN(0)) { for (int rep = 0; rep < NREP(0); ++rep) prep_phase(lds, a, wv64_); }
    SEAM(0);
    if (PROBE_PHASE == 100) { for (int rep = 0; rep < PROBE_REP; ++rep) xcd_barrier(bar, opaque_tid() == 0); }
    const int mb8 = (int)gridDim.x >= 128 ? (int)gridDim.x - 32 : 0;
#pragma unroll 1
    for (int l = 0; l < 2; ++l) {
        const int pb = 1 + 3 * l;
        unsigned char* wb = ws + WS_WA + (size_t)l * WA_STRIDE;
        if (IN(pb)) for (int rep = 0; rep < NREP(pb); ++rep) {
            EpiInA E{SS + l * MROWS, SSM + l * 16, U, G};
            if (l == 1 && opaque_bid() < 64) META_WAIT(0);
            for (int jb = opaque_bid(); jb < 64; jb += (int)gridDim.x) meta_gemm_job32(lds, XB + (size_t)MPOS * DM, (const bf16_t*)wb, jb, E, wv64_);
            if (l == 1) PANEL_WAIT(0);
#if GEMM_FAST
            { pg8::Gemm g{XB, (const bf16_t*)wb, MROWS, 2048, DM}; pg8::StaticOrder S; S.init(MROWS, 2048, (int)gridDim.x, (int)blockIdx.x);
              pg8::FastInA E2{SS + l * MROWS, ws};
              pg8::gemm_phase<pg8::FastInA, pg8::StaticOrder, true, true>(lds, g, S, E2, wv64_); }
#else
            naive_gemm_phase(lds, XB, (const bf16_t*)wb, 2048, E, wv64_);
#endif
        }
        SEAM(pb);
#if SCAN_FAST
        if (IN(pb + 1)) { for (int rep = 0; rep < NREP(pb + 1); ++rep) scan_phase_fast(lds, a, l, wv64_);
            if (PROBE_PHASE >= 200 && l == 0) { for (int rep = 0; rep < PROBE_REP; ++rep) scan_phase_fast<(PROBE_PHASE >= 200 ? PROBE_PHASE - 200 : 0)>(lds, a, l, wv64_); } }
#else
        if (IN(pb + 1)) { scan_phase_simple(lds, a, l, wv64_); }
#endif
        SEAM(pb + 1);
        if (IN(pb + 2)) for (int rep = 0; rep < NREP(pb + 2); ++rep) {
            const int lastrep = (rep + 1 < NREP(pb + 2)) ? 1 : 0;
            EpiOut E{a.in[I_X], a.out, XFM, XB, SS + (l + 1) * MROWS, SSM + (l + 1) * 16, l == 0 ? 0 : 1};
            if (opaque_bid() >= mb8 && !lastrep) { bool any_ = false; for (int jb = opaque_bid() - mb8; jb < 32; jb += (int)gridDim.x) { meta_gemm_job32(lds, YG + (size_t)MPOS * DM, (const bf16_t*)(wb + WA_WOUT), jb, E, wv64_); any_ = true; } if (any_) META_ARRIVE(l); }
#if GEMM_FAST
            { pg8::Gemm g{YG, (const bf16_t*)(wb + WA_WOUT), MROWS, 1024, DM}; pg8::StaticOrder S; S.init(MROWS, 1024, (int)gridDim.x, (int)blockIdx.x);
              pg8::FastOut E2{a.in[I_X], a.out, XB, SS + (l + 1) * MROWS, 1};
              pg8::gemm_phase<pg8::FastOut, pg8::StaticOrder, false, true>(lds, g, S, E2, wv64_);
              PANEL_ARRIVE(l); }
#else
            naive_gemm_phase(lds, YG, (const bf16_t*)(wb + WA_WOUT), 1024, E, wv64_);
#endif
        }
        PSEAM(pb + 2);
    }
    if (IN(7)) for (int rep = 0; rep < NREP(7); ++rep) {
        EpiQKV E{SS + 2 * MROWS, SSM + 2 * 16, a.in[I_KNORM], a.in[I_QNORM], ws, 0};
        if (opaque_bid() < 128) META_WAIT(1);
        for (int jb = opaque_bid(); jb < 128; jb += (int)gridDim.x) meta_gemm_job32(lds, XB + (size_t)MPOS * DM, (const bf16_t*)(ws + WS_WKVQ), jb, E, wv64_, 0);
        PANEL_WAIT(1);
        f_phase(a, wv64_);
#if GEMM_FAST
        { pg8::Gemm g{XB, (const bf16_t*)(ws + WS_WKVQ), MROWS, 4096, DM}; pg8::StaticOrder S; S.init(MROWS, 4096, (int)gridDim.x, (int)blockIdx.x);
          pg8::FastQKV E2{SS + 2 * MROWS, a.in[I_KNORM], a.in[I_QNORM], ws, (LAS float*)(lds + EPI_OFF), 0};
          pg8::gemm_phase<pg8::FastQKV, pg8::StaticOrder, true, true>(lds, g, S, E2, wv64_);
          if (PROBE_PHASE == 300) { for (int r2 = 0; r2 < PROBE_REP; ++r2) { pg8::NullEpi E3; pg8::gemm_phase<pg8::NullEpi, pg8::StaticOrder, true, true>(lds, g, S, E3, wv64_); } } }
#else
        naive_gemm_phase(lds, XB, (const bf16_t*)(ws + WS_WKVQ), 4096, E, wv64_);
#endif
    }
    SEAM(7);
#if ATTN_FAST
    if (IN(8)) for (int rep = 0; rep < NREP(8); ++rep) { attn_meta_rows(a, wv64_); attn_phase_fast((char*)lds_raw, a, a.in[I_QNORM], 2 * rep, wv64_); }
#else
    if (IN(8)) { attn_phase_naive(a, wv64_); }
#endif
    SEAM(8);
    if (IN(9)) {
        EpiOut E{a.in[I_X], a.out, XFM, XB, SS + 3 * MROWS, SSM + 3 * 16, 1};
        if (opaque_bid() >= mb8) { bool any_ = false; for (int jb = opaque_bid() - mb8; jb < 32; jb += (int)gridDim.x) { meta_gemm_job32(lds, YG + (size_t)MPOS * DM, (const bf16_t*)(ws + WS_WOUTB), jb, E, wv64_); any_ = true; } if (any_) META_ARRIVE(2); }
#if GEMM_FAST
        { pg8::Gemm g{YG, (const bf16_t*)(ws + WS_WOUTB), MROWS, 1024, DM}; pg8::StaticOrder S; S.init(MROWS, 1024, (int)gridDim.x, (int)blockIdx.x);
          pg8::FastOut E2{a.in[I_X], a.out, XB, SS + 3 * MROWS, 1};
          pg8::gemm_phase<pg8::FastOut, pg8::StaticOrder, false, true>(lds, g, S, E2, wv64_);
          PANEL_ARRIVE(2); }
#else
        naive_gemm_phase(lds, YG, (const bf16_t*)(ws + WS_WOUTB), 1024, E, wv64_);
#endif
    }
    PSEAM(9);
    if (IN(10)) for (int rep = 0; rep < NREP(10); ++rep) {
        EpiQKV E{SS + 3 * MROWS, SSM + 3 * 16, a.in[I_KNORM], a.in[I_QNORM] + HD, ws, 2};
        if (opaque_bid() < 64) META_WAIT(2);
        for (int jb = opaque_bid(); jb < 64; jb += (int)gridDim.x) meta_gemm_job32(lds, XB + (size_t)MPOS * DM, (const bf16_t*)(ws + WS_WINB1), jb, E, wv64_, 1);
        PANEL_WAIT(2);
#if GEMM_FAST
        { pg8::Gemm g{XB, (const bf16_t*)(ws + WS_WINB1), MROWS, 2048, DM}; pg8::StaticOrder S; S.init(MROWS, 2048, (int)gridDim.x, (int)blockIdx.x);
          pg8::FastQKV E2{SS + 3 * MROWS, a.in[I_KNORM], a.in[I_QNORM] + HD, ws, (LAS float*)(lds + EPI_OFF), 2};
          pg8::gemm_phase<pg8::FastQKV, pg8::StaticOrder, true, true>(lds, g, S, E2, wv64_); }
#else
        naive_gemm_phase(lds, XB, (const bf16_t*)(ws + WS_WINB1), 2048, E, wv64_);
#endif
    }
    SEAM(10);
#if ATTN_FAST
    if (IN(11)) { attn_meta_rows(a, wv64_); attn_phase_fast((char*)lds_raw, a, a.in[I_QNORM] + HD, 1, wv64_); }
#else
    if (IN(11)) { attn_phase_naive(a, wv64_); }
#endif
    SEAM(11);
    if (IN(12)) {
        EpiOut E{a.in[I_X], a.out, XFM, XB, SS, SSM, 2};
#if GEMM_FAST
        { pg8::Gemm g{YG, (const bf16_t*)(ws + WS_WOUTB) + (size_t)DM * DM, MROWS, 1024, DM}; pg8::StaticOrder S; S.init(MROWS, 1024, (int)gridDim.x, (int)blockIdx.x);
          pg8::FastOut E2{a.in[I_X], a.out, XB, SS, 2};
          pg8::gemm_phase<pg8::FastOut, pg8::StaticOrder, false, true>(lds, g, S, E2, wv64_); }
#else
        naive_gemm_phase(lds, YG, (const bf16_t*)(ws + WS_WOUTB) + (size_t)DM * DM, 1024, E, wv64_);
#endif
    }
#undef IN
#undef SEAM
}

extern "C" void kernel_launch(void* const* d_in, const int* in_sizes, int n_in, void* d_out, int out_size, void* d_ws, size_t ws_size, hipStream_t stream) {
    static int grid = 0;
    if (grid == 0) {
        if (n_in != 20 || out_size != MROWS * DM || ws_size < WS_END + 16 * 4096 * 4) { fprintf(stderr, "kernel_launch: unexpected shapes (n_in %d out %d ws %zu)\n", n_in, out_size, ws_size); grid = -1; return; }
        int dev = 0, cus = 0, per_cu = 0;
        if (hipGetDevice(&dev) != hipSuccess || hipDeviceGetAttribute(&cus, hipDeviceAttributeMultiprocessorCount, dev) != hipSuccess) { grid = -1; return; }
        if (hipFuncSetAttribute((const void*)yoco_fwd, hipFuncAttributeMaxDynamicSharedMemorySize, LDS_BYTES) != hipSuccess) { fprintf(stderr, "kernel_launch: hipFuncSetAttribute failed\n"); grid = -1; return; }
        if (hipOccupancyMaxActiveBlocksPerMultiprocessor(&per_cu, (const void*)yoco_fwd, NTHREADS, LDS_BYTES) != hipSuccess || per_cu < 1) { fprintf(stderr, "kernel_launch: occupancy query says %d blocks per CU\n", per_cu); per_cu = 1; }
        (void)hipGetLastError();
        grid = cus < 256 ? cus : 256;
    }
    if (grid < 0) return;
    (void)hipMemsetAsync((char*)d_ws + WS_CTL, 0, CTL_ZERO_BYTES, stream);
    Args a{};
    for (int i = 0; i < 20; ++i) a.in[i] = (const float*)d_in[i];
    a.out = (float*)d_out; a.ws = (unsigned char*)d_ws;
#if MK_PER_PHASE
    for (int p = 0; p < NPHASES; ++p) { a.ph_lo = p; a.ph_hi = p + 1; hipLaunchKernelGGL(yoco_fwd, dim3(grid), dim3(NTHREADS), LDS_BYTES, stream, a); }
#else
    a.ph_lo = 0; a.ph_hi = NPHASES;
    hipLaunchKernelGGL(yoco_fwd, dim3(grid), dim3(NTHREADS), LDS_BYTES, stream, a);
#endif
}
```
